# Optimizing an MI355X kernel written in HIP

```python
import jax, jax.numpy as jnp
from jax import lax
import numpy as np


D_MODEL = 1024
BATCH = 8
SEQ = 4096
DEPTH = 2

N_A_LAYERS = DEPTH // 2
N_B_LAYERS = DEPTH - N_A_LAYERS
HG_EXPAND = 128
HG_HEADS = D_MODEL // HG_EXPAND
HG_DV = D_MODEL // HG_HEADS
HG_CHUNK = 32
ATT_HEAD_DIM = 64
ATT_Q_HEADS = D_MODEL // ATT_HEAD_DIM
ATT_KV_HEADS = 2
ATT_GROUP = ATT_Q_HEADS // ATT_KV_HEADS
WINDOW = 128
D_FF = 2816
CONV_WIDTH = 3
EPS = 1e-6

kernel_name = 'yoco_hgrn2_swa_sink_alibi_convffn'

F32 = jnp.float32


def rms_norm(x, g):
    xf = x.astype(F32)
    xf = xf * lax.rsqrt(jnp.mean(xf * xf, axis=-1, keepdims=True) + EPS)
    return (xf * g.astype(F32)).astype(x.dtype)


def alibi_slopes(n_heads):
    return jnp.asarray(2.0 ** (-8.0 * np.arange(1, n_heads + 1) / n_heads), F32)


def hgrn2_chunked(q, k, v, logf):
    b_, s_, h_, dk = q.shape
    dv = v.shape[-1]
    n_chunks = s_ // HG_CHUNK

    def to_chunks(t):
        return t.reshape(b_, n_chunks, HG_CHUNK, h_, t.shape[-1]).transpose(1, 0, 3, 2, 4)

    qc, kc, vc, gc = to_chunks(q), to_chunks(k), to_chunks(v), to_chunks(logf)
    causal = jnp.tril(jnp.ones((HG_CHUNK, HG_CHUNK), bool))[:, :, None]

    def step(state, inp):
        qb, kb, vb, gb = inp
        cum = jnp.cumsum(gb, axis=2)
        o_inter = jnp.einsum('bhtk,bhkv->bhtv', qb * jnp.exp(cum), state)
        rel = cum[:, :, :, None, :] - cum[:, :, None, :, :]
        decay = jnp.exp(jnp.where(causal, rel, -jnp.inf))
        scores = jnp.einsum('bhtk,bhsk,bhtsk->bhts', qb, kb, decay)
        o_intra = jnp.einsum('bhts,bhsv->bhtv', scores, vb)
        last = cum[:, :, -1:, :]
        new_state = (jnp.exp(last[:, :, 0, :])[..., None] * state
                     + jnp.einsum('bhsk,bhsv->bhkv', kb * jnp.exp(last - cum), vb))
        return new_state, o_inter + o_intra

    s0 = jnp.zeros((b_, h_, dk, dv), F32)
    _, o = lax.scan(step, s0, (qc, kc, vc, gc))
    return o.transpose(1, 0, 3, 2, 4).reshape(b_, s_, h_, dv)


def hgrn2_mixer(x, w_in, lower_bound, out_norm, w_out):
    b_, s_, _ = x.shape
    q, f, i, g = jnp.split(x @ w_in, 4, axis=-1)
    q = jax.nn.silu(q.astype(F32)) * HG_EXPAND ** -0.5
    forget = lower_bound + (1.0 - lower_bound) * jax.nn.sigmoid(f.astype(F32))
    logf = jnp.log(forget)
    k = 1.0 - forget
    heads = lambda t: t.reshape(b_, s_, HG_HEADS, -1)
    o = hgrn2_chunked(heads(q), heads(k), heads(i.astype(F32)), heads(logf))
    o = rms_norm(o, out_norm) * jax.nn.silu(heads(g.astype(F32)))
    return o.reshape(b_, s_, D_MODEL).astype(x.dtype) @ w_out


def shared_kv(h, kv_norm, w_kv):
    b_, s_, _ = h.shape
    k, v = jnp.split(rms_norm(h, kv_norm) @ w_kv, 2, axis=-1)
    return (k.reshape(b_, s_, ATT_KV_HEADS, ATT_HEAD_DIM),
            v.reshape(b_, s_, ATT_KV_HEADS, ATT_HEAD_DIM))


def swa_sink_attention(x, k, v, w_q, sinks, w_o):
    b_, s_, _ = x.shape
    nb = s_ // WINDOW
    q = (x @ w_q).reshape(b_, nb, WINDOW, ATT_KV_HEADS, ATT_GROUP, ATT_HEAD_DIM)

    def band(t):
        tb = t.reshape(b_, nb, WINDOW, ATT_KV_HEADS, ATT_HEAD_DIM)
        prev = jnp.pad(tb[:, :-1], ((0, 0), (1, 0), (0, 0), (0, 0), (0, 0)))
        return jnp.concatenate([prev, tb], axis=2)

    kb, vb = band(k), band(v)
    scores = jnp.einsum('bnqkgd,bnskd->bnkgqs', q.astype(F32), kb.astype(F32)) * ATT_HEAD_DIM ** -0.5
    q_idx = jnp.arange(WINDOW)[:, None] + WINDOW
    k_idx = jnp.arange(2 * WINDOW)[None, :]
    dist = q_idx - k_idx
    key_abs = (jnp.arange(nb) * WINDOW)[:, None] + jnp.arange(2 * WINDOW)[None, :] - WINDOW
    valid = ((dist >= 0) & (dist < WINDOW))[None] & (key_abs >= 0)[:, None, :]
    slopes = alibi_slopes(ATT_Q_HEADS).reshape(ATT_KV_HEADS, ATT_GROUP)
    scores = scores - slopes[:, :, None, None] * dist.astype(F32)
    scores = jnp.where(valid[None, :, None, None], scores, -jnp.inf)
    sink = sinks.astype(F32).reshape(ATT_KV_HEADS, ATT_GROUP)[None, None, :, :, None, None]
    m = jnp.maximum(jnp.max(scores, axis=-1, keepdims=True), sink)
    e = jnp.exp(scores - m)
    probs = e / (jnp.sum(e, axis=-1, keepdims=True) + jnp.exp(sink - m))
    out = jnp.einsum('bnkgqs,bnskd->bnqkgd', probs, vb.astype(F32))
    return out.reshape(b_, s_, ATT_Q_HEADS * ATT_HEAD_DIM).astype(x.dtype) @ w_o


def conv_ffn(x, w_up, conv_w, conv_b, w_down):
    s_ = x.shape[1]
    gate, val = jnp.split(x @ w_up, 2, axis=-1)
    gp = jnp.pad(gate, ((0, 0), (CONV_WIDTH - 1, 0), (0, 0)))
    conv = conv_b
    for j in range(CONV_WIDTH):
        conv = conv + conv_w[j] * gp[:, j:j + s_]
    return (jax.nn.silu(conv) * val) @ w_down


def setup_inputs(seed: int = 0) -> dict:
    key = jax.random.key(seed)
    ks = jax.random.split(key, 18)
    D = D_MODEL
    HQD = ATT_Q_HEADS * ATT_HEAD_DIM
    KVD = ATT_KV_HEADS * ATT_HEAD_DIM

    def w(k, shape, fan_in):
        return jax.random.normal(k, shape, F32) * fan_in ** -0.5

    def gain(k, shape):
        return 1.0 + 0.02 * jax.random.normal(k, shape, F32)

    return {
        'x': jax.random.normal(ks[0], (BATCH, SEQ, D), F32),
        'hg_norm': gain(ks[1], (N_A_LAYERS, D)),
        'hg_w_in': w(ks[2], (N_A_LAYERS, D, 4 * D), D),
        'hg_lb_logits': 0.1 * jax.random.normal(ks[3], (N_A_LAYERS + 1, D), F32),
        'hg_out_norm': gain(ks[4], (N_A_LAYERS, HG_DV)),
        'hg_w_out': w(ks[5], (N_A_LAYERS, D, D), D),
        'kv_norm': gain(ks[6], (D,)),
        'w_kv': w(ks[7], (D, 2 * KVD), D),
        'attn_norm': gain(ks[8], (N_B_LAYERS, D)),
        'attn_w_q': w(ks[9], (N_B_LAYERS, D, HQD), D),
        'attn_sinks': 0.5 * jax.random.normal(ks[10], (N_B_LAYERS, ATT_Q_HEADS), F32),
        'attn_w_o': w(ks[11], (N_B_LAYERS, HQD, D), HQD),
        'ffn_norm': gain(ks[12], (DEPTH, D)),
        'ffn_w_up': w(ks[13], (DEPTH, D, 2 * D_FF), D),
        'ffn_conv_w': w(ks[14], (DEPTH, CONV_WIDTH, D_FF), CONV_WIDTH),
        'ffn_conv_b': 0.02 * jax.random.normal(ks[15], (DEPTH, D_FF), F32),
        'ffn_w_down': w(ks[16], (DEPTH, D_FF, D), D_FF),
        'final_norm': gain(ks[17], (D,)),
    }


def reference(x, hg_norm, hg_w_in, hg_lb_logits, hg_out_norm, hg_w_out, kv_norm, w_kv,
              attn_norm, attn_w_q, attn_sinks, attn_w_o, ffn_norm, ffn_w_up, ffn_conv_w,
              ffn_conv_b, ffn_w_down, final_norm):
    lower_bounds = jnp.cumsum(jax.nn.softmax(hg_lb_logits.astype(F32), axis=0), axis=0)
    h = x
    k_sh, v_sh = None, None
    for layer in range(DEPTH):
        if layer < N_A_LAYERS:
            a = layer
            h = h + hgrn2_mixer(rms_norm(h, hg_norm[a]), hg_w_in[a], lower_bounds[a],
                                hg_out_norm[a], hg_w_out[a])
        else:
            bi = layer - N_A_LAYERS
            if bi == 0:
                k_sh, v_sh = shared_kv(h, kv_norm, w_kv)
            h = h + swa_sink_attention(rms_norm(h, attn_norm[bi]), k_sh, v_sh,
                                       attn_w_q[bi], attn_sinks[bi], attn_w_o[bi])
        h = h + conv_ffn(rms_norm(h, ffn_norm[layer]), ffn_w_up[layer], ffn_conv_w[layer],
                         ffn_conv_b[layer], ffn_w_down[layer])
    return rms_norm(h, final_norm)
```

```cpp
#include <hip/hip_runtime.h>
#include <hip/hip_cooperative_groups.h>
#include <cstdio>
#include <cstdint>
namespace cg = cooperative_groups;

#define LAS __attribute__((address_space(3)))
typedef unsigned short bf16_t;
typedef short bf16x8 __attribute__((ext_vector_type(8)));
typedef short s16x4 __attribute__((ext_vector_type(4)));
typedef float f32x4 __attribute__((ext_vector_type(4)));
typedef unsigned u32x4 __attribute__((ext_vector_type(4)));
typedef unsigned u32x2 __attribute__((ext_vector_type(2)));

constexpr int D = 1024, BATCH = 8, SEQ = 4096, M = BATCH * SEQ, DFF = 2816;
constexpr float EPS = 1e-6f;
constexpr float LOG2E = 1.4426950408889634f;

constexpr size_t MiB = 1u << 20;
constexpr size_t WS_RS = 0;
constexpr size_t WS_BAR = 768 * 1024;
constexpr size_t WS_WIN = 1 * MiB, WS_WOUT = 9 * MiB, WS_WUP0 = 11 * MiB, WS_WD0 = 22 * MiB, WS_WQKV = 28 * MiB, WS_WO = 31 * MiB, WS_WUP1 = 33 * MiB, WS_WD1 = 44 * MiB;
constexpr size_t WS_HB = 51 * MiB;
constexpr size_t WS_H = 116 * MiB;
constexpr size_t WS_T = 244 * MiB;
constexpr size_t WS_QT = WS_T, WS_FT = WS_T + 64 * MiB, WS_IT = WS_T + 128 * MiB, WS_AO = WS_T + 192 * MiB, WS_GT = WS_H, WS_OI = WS_H + 64 * MiB, WS_DC = WS_T + 256 * MiB;
constexpr size_t WS_U = WS_T;
constexpr size_t WS_QB = WS_T, WS_KB = WS_T + 64 * MiB, WS_VT = WS_T + 72 * MiB, WS_OB = WS_T + 80 * MiB;
constexpr size_t WS_END = 512 * MiB;

typedef float f32x2_t __attribute__((ext_vector_type(2))); typedef __bf16 bf16x2_t __attribute__((ext_vector_type(2)));
__device__ __forceinline__ unsigned cvt_pk_bf16(float lo, float hi) { const f32x2_t v = {lo, hi}; const bf16x2_t r = __builtin_convertvector(v, bf16x2_t); return __builtin_bit_cast(unsigned, r); }
__device__ __forceinline__ bf16_t f2bf(float f) { return (bf16_t)(cvt_pk_bf16(f, 0.f) & 0xffffu); }
__device__ __forceinline__ float bf_lo(unsigned u) { return __uint_as_float(u << 16); }
__device__ __forceinline__ float bf_hi(unsigned u) { return __uint_as_float(u & 0xffff0000u); }
__device__ __forceinline__ float ex2(float x) { return __builtin_amdgcn_exp2f(x); }
__device__ __forceinline__ float rcpf_(float x) { return __builtin_amdgcn_rcpf(x); }
__device__ __forceinline__ float sigmoid_f(float v) { return rcpf_(1.f + ex2(-LOG2E * v)); }
__device__ __forceinline__ float silu_f(float v) { return v * sigmoid_f(v); }
template <int CTRL> __device__ __forceinline__ float row_ror_t(float v) { return __builtin_bit_cast(float, __builtin_amdgcn_update_dpp(0, __builtin_bit_cast(int, v), CTRL, 0xf, 0xf, false)); }
#define row_ror_f(v, ctrl) row_ror_t<ctrl>(v)
#define LDS_WAIT() asm volatile("s_waitcnt lgkmcnt(0)" ::: "memory")
#define WG_BAR() do { asm volatile("s_waitcnt lgkmcnt(0)" ::: "memory"); __builtin_amdgcn_s_barrier(); asm volatile("" ::: "memory"); } while (0)

namespace pg8 {
constexpr int BM = 256, BK = 64, HALF = 128, HTB = HALF * BK * 2, STAGE_BYTES = 8 * HTB, NXCD = 8, WGM = 8;
__host__ __device__ __forceinline__ int lds_byte(int r, int c) { const int st = (r >> 4) * 2 + (c >> 5), rr = r & 15, cc = c & 31, ob = rr * 64 + cc * 2; return st * 1024 + (ob ^ (((ob >> 9) & 1) << 5)); }
__host__ __device__ __forceinline__ int perm32(int rho) { const int n = rho >> 4, i = rho & 15; return 8 * (i >> 2) + 4 * n + (i & 3); }
__host__ __device__ __forceinline__ void stage_rc(int b, int& R, int& C) { const int st = b / 1024, sb = b % 1024, swz = sb ^ (((sb >> 9) & 1) << 5); R = (st >> 1) * 16 + swz / 64; C = (st & 1) * 32 + (swz % 64) / 2; }

struct Unit { int pm, pn, arow; };
struct Gemm { const bf16_t* A; const bf16_t* Bt; int M, N, K; };

struct StaticOrder {
    int nM, nN, nwg, G, c, ovl;
    __device__ void init(int nM_, int nN_, int G_, int c_, int ovl_) { nM = nM_; nN = nN_; nwg = nM * nN; G = G_; c = c_; ovl = ovl_; }
    __device__ bool next(int i, Unit& u) const {
        const long L = (long)i * G + c; if (L >= nwg) return false;
        int wgid = (int)L; { const int q = nwg / NXCD, r = nwg % NXCD, xcd = wgid % NXCD, off = wgid / NXCD; wgid = (xcd < r ? xcd * (q + 1) : r * (q + 1) + (xcd - r) * q) + off; }
        const int nig = WGM * nN, gid = wgid / nig, fm = gid * WGM, gsz = (nM - fm) < WGM ? (nM - fm) : WGM;
        u.pm = fm + ((wgid % nig) % gsz); u.pn = (wgid % nig) / gsz;
        u.arow = ovl ? (u.pm / 17) * SEQ + 254 * (u.pm % 17) - 2 : u.pm * BM;
        return true;
    }
};

template <class Epi, bool SWAP, bool PERM = false>
__device__ __forceinline__ void gemm_phase(LAS unsigned char* lds, const Gemm g, const StaticOrder& S, const Epi& E) {
    int tid = threadIdx.x; asm volatile("" : "+v"(tid));
    const int wid = __builtin_amdgcn_readfirstlane(tid >> 6), lane = tid & 63, wr = wid >> 2, wc = wid & 3, fr = lane & 15, fq = lane >> 4;
    const int K = g.K, nt = K / BK;
    unsigned voffA[2], voffB[2];
#pragma unroll
    for (int i = 0; i < 2; ++i) { int R, C; stage_rc(tid * 16 + i * 8192, R, C); voffA[i] = (unsigned)(R * K + C) * 2u; const int Rb = PERM ? ((R & ~31) + perm32(R & 31)) : R; voffB[i] = (unsigned)(Rb * K + C) * 2u; }
    const size_t kstep = (size_t)(BK * 2);
    const size_t hstep = (size_t)HALF * K * 2;
    const size_t tstep = 2 * hstep;
    const long rowb = (long)K * 2;
    const unsigned ldsw = (unsigned)wid * 1024u;
    const int aoff = lds_byte(wr * 64 + fr, fq * 8), boff = lds_byte(wc * 32 + fr, fq * 8);
#define PG8_SA(b, h) (((b) * 2 + (h)) * HTB)
#define PG8_SB(b, h) ((4 + (b) * 2 + (h)) * HTB)
#define PG8_STAGE(bufoff, gbase, voff) do { _Pragma("unroll") for (int _i = 0; _i < 2; ++_i) \
        __builtin_amdgcn_global_load_lds((const unsigned*)((const char*)(gbase) + (voff)[_i]), (LAS unsigned*)(lds + (bufoff) + ldsw + _i * 8192), 16, 0, 0); } while (0)
#define PG8_LDA(dst, b, h) do { _Pragma("unroll") for (int m = 0; m < 4; ++m) _Pragma("unroll") for (int k = 0; k < 2; ++k) dst[m][k] = *(const LAS bf16x8*)(lds + PG8_SA(b, h) + aoff + m * 2048 + k * 1024); } while (0)
#define PG8_LDB(dst, b, h) do { _Pragma("unroll") for (int n = 0; n < 2; ++n) _Pragma("unroll") for (int k = 0; k < 2; ++k) dst[n][k] = *(const LAS bf16x8*)(lds + PG8_SB(b, h) + boff + n * 2048 + k * 1024); } while (0)
#define PG8_MMA(ai, bj, At, Bt) do { __builtin_amdgcn_s_setprio(1); _Pragma("unroll") for (int m = 0; m < 4; ++m) _Pragma("unroll") for (int n = 0; n < 2; ++n) _Pragma("unroll") for (int k = 0; k < 2; ++k) { \
        if constexpr (SWAP) acc[ai][bj][m][n] = __builtin_amdgcn_mfma_f32_16x16x32_bf16(At[m][k], Bt[n][k], acc[ai][bj][m][n], 0, 0, 0); \
        else acc[ai][bj][m][n] = __builtin_amdgcn_mfma_f32_16x16x32_bf16(Bt[n][k], At[m][k], acc[ai][bj][m][n], 0, 0, 0); } __builtin_amdgcn_s_setprio(0); } while (0)
#define PG8_WAIT_V(n) asm volatile("s_waitcnt vmcnt(" #n ")" ::: "memory")
#define PG8_WAIT_L(n) asm volatile("s_waitcnt lgkmcnt(" #n ")" ::: "memory")
#define PG8_BAR __builtin_amdgcn_s_barrier()
#define PG8_SCHED __builtin_amdgcn_sched_barrier(0)
    Unit cur, nxt; int ui = 0;
    if (!S.next(0, cur)) return;
    f32x4 acc[2][2][4][2];
#pragma unroll
    for (int a = 0; a < 2; ++a)
#pragma unroll
        for (int b = 0; b < 2; ++b)
#pragma unroll
            for (int m = 0; m < 4; ++m)
#pragma unroll
                for (int n = 0; n < 2; ++n) acc[a][b][m][n] = (f32x4){0.f, 0.f, 0.f, 0.f};
    bf16x8 At[4][2], B0[2][2], B1[2][2];
    const char* cA = (const char*)g.A + (long)cur.arow * rowb; const char* cB = (const char*)g.Bt + (size_t)cur.pn * tstep;
    PG8_STAGE(PG8_SB(0, 0), cB, voffB); PG8_STAGE(PG8_SB(0, 1), cB + hstep, voffB); PG8_STAGE(PG8_SA(0, 0), cA, voffA); PG8_STAGE(PG8_SA(0, 1), cA + hstep, voffA);
    if (wr == 1) PG8_BAR;
    PG8_WAIT_V(2); PG8_BAR;
    PG8_STAGE(PG8_SB(1, 0), cB + kstep, voffB); PG8_STAGE(PG8_SA(1, 0), cA + kstep, voffA); PG8_STAGE(PG8_SB(1, 1), cB + hstep + kstep, voffB);
    PG8_WAIT_V(6); PG8_BAR;
    for (;;) {
        const bool has_next = S.next(ui + 1, nxt);
        const char* nA = has_next ? (const char*)g.A + (long)nxt.arow * rowb : cA; const char* nB = has_next ? (const char*)g.Bt + (size_t)nxt.pn * tstep : cB;
        for (int t = 0; t < nt; t += 2) {
            const bool last = (t == nt - 2);
            const char* a1 = cA + (size_t)(t + 1) * kstep;
            const char* a2 = last ? nA : cA + (size_t)(t + 2) * kstep; const char* b2 = last ? nB : cB + (size_t)(t + 2) * kstep;
            const char* a3 = a2 + kstep; const char* b3 = b2 + kstep;
            PG8_LDB(B0, 0, 0); PG8_LDB(B1, 0, 1); PG8_SCHED; PG8_LDA(At, 0, 0); PG8_STAGE(PG8_SA(1, 1), a1 + hstep, voffA);
            PG8_WAIT_V(8); PG8_WAIT_L(0); PG8_BAR; PG8_MMA(0, 0, At, B0); PG8_MMA(0, 1, At, B1); PG8_BAR; PG8_SCHED;
            PG8_LDA(At, 0, 1); PG8_STAGE(PG8_SB(0, 0), b2, voffB); PG8_STAGE(PG8_SB(0, 1), b2 + hstep, voffB); PG8_STAGE(PG8_SA(0, 0), a2, voffA);
            PG8_WAIT_V(8); PG8_WAIT_L(0); PG8_BAR; PG8_MMA(1, 0, At, B0); PG8_MMA(1, 1, At, B1); PG8_BAR; PG8_SCHED;
            PG8_LDB(B0, 1, 0); PG8_LDB(B1, 1, 1); PG8_SCHED; PG8_LDA(At, 1, 0); PG8_STAGE(PG8_SA(0, 1), a2 + hstep, voffA);
            PG8_WAIT_V(8); PG8_WAIT_L(0); PG8_BAR; PG8_MMA(0, 0, At, B0); PG8_MMA(0, 1, At, B1); PG8_BAR; PG8_SCHED;
            PG8_LDA(At, 1, 1); PG8_STAGE(PG8_SB(1, 0), b3, voffB); PG8_STAGE(PG8_SB(1, 1), b3 + hstep, voffB); PG8_STAGE(PG8_SA(1, 0), a3, voffA);
            PG8_WAIT_V(8); PG8_WAIT_L(0); PG8_BAR; PG8_MMA(1, 0, At, B0); PG8_MMA(1, 1, At, B1); PG8_BAR; PG8_SCHED;
        }
        if (wr == 0) PG8_BAR;
        E(acc, cur, wr, wc, fr, fq);
        if (!has_next) break;
#pragma unroll
        for (int a = 0; a < 2; ++a)
#pragma unroll
            for (int b = 0; b < 2; ++b)
#pragma unroll
                for (int m = 0; m < 4; ++m)
#pragma unroll
                    for (int n = 0; n < 2; ++n) acc[a][b][m][n] = (f32x4){0.f, 0.f, 0.f, 0.f};
        cur = nxt; cA = nA; cB = nB; ++ui;
        if (wr == 1) PG8_BAR;
    }
    PG8_WAIT_V(0);
    PG8_BAR;
#undef PG8_SA
#undef PG8_SB
#undef PG8_STAGE
#undef PG8_LDA
#undef PG8_LDB
#undef PG8_MMA
#undef PG8_WAIT_V
#undef PG8_WAIT_L
#undef PG8_BAR
#undef PG8_SCHED
}


struct EpiRes {
    bf16_t* hb; float* rowss;
    __device__ __forceinline__ void operator()(const f32x4 (&acc)[2][2][4][2], const Unit& u, int wr, int wc, int fr, int fq) const {
#pragma unroll
        for (int ai = 0; ai < 2; ++ai)
#pragma unroll
            for (int m = 0; m < 4; ++m) {
                const int row = u.pm * BM + ai * HALF + wr * 64 + m * 16 + fr; float ss = 0.f;
#pragma unroll
                for (int bj = 0; bj < 2; ++bj) {
                    const size_t off = (size_t)row * D + u.pn * BM + bj * HALF + wc * 32 + 8 * fq;
                    const u32x4 hv = *(const u32x4*)(hb + off);
                    f32x4 v0 = acc[ai][bj][m][0], v1 = acc[ai][bj][m][1];
                    v0[0] += bf_lo(hv[0]); v0[1] += bf_hi(hv[0]); v0[2] += bf_lo(hv[1]); v0[3] += bf_hi(hv[1]);
                    v1[0] += bf_lo(hv[2]); v1[1] += bf_hi(hv[2]); v1[2] += bf_lo(hv[3]); v1[3] += bf_hi(hv[3]);
                    *(u32x4*)(hb + off) = (u32x4){cvt_pk_bf16(v0[0], v0[1]), cvt_pk_bf16(v0[2], v0[3]), cvt_pk_bf16(v1[0], v1[1]), cvt_pk_bf16(v1[2], v1[3])};
                    ss += ((v0[0] * v0[0] + v0[1] * v0[1]) + (v0[2] * v0[2] + v0[3] * v0[3])) + ((v1[0] * v1[0] + v1[1] * v1[1]) + (v1[2] * v1[2] + v1[3] * v1[3]));
                }
                ss += __shfl_xor(ss, 16); ss += __shfl_xor(ss, 32);
                if (fq == 0) unsafeAtomicAdd(rowss + row, ss);
                asm volatile("" ::: "memory");
            }
    }
};

struct EpiQkv {
    bf16_t* QB; bf16_t* KB; bf16_t* VT; const float* rowss;
    __device__ __forceinline__ void operator()(const f32x4 (&acc)[2][2][4][2], const Unit& u, int wr, int wc, int fr, int fq) const {
        float ssq[8];
#pragma unroll
        for (int i = 0; i < 8; ++i) ssq[i] = rowss[u.pm * BM + (i >> 2) * HALF + wr * 64 + (i & 3) * 16 + fr];
        asm volatile("" ::: "memory");
#pragma unroll
        for (int ai = 0; ai < 2; ++ai)
#pragma unroll
            for (int m = 0; m < 4; ++m) {
                const int row = u.pm * BM + ai * HALF + wr * 64 + m * 16 + fr;
                const float rs = rsqrtf(ssq[ai * 4 + m] * (1.f / D) + EPS);
#pragma unroll
                for (int bj = 0; bj < 2; ++bj) {
                    const f32x4 v0 = acc[ai][bj][m][0] * rs, v1 = acc[ai][bj][m][1] * rs; const int cl = wc * 32 + 8 * fq;
                    const u32x4 w = (u32x4){cvt_pk_bf16(v0[0], v0[1]), cvt_pk_bf16(v0[2], v0[3]), cvt_pk_bf16(v1[0], v1[1]), cvt_pk_bf16(v1[2], v1[3])};
                    if (u.pn < 4) *(u32x4*)(QB + (size_t)row * D + u.pn * BM + bj * HALF + cl) = w;
                    else if (bj == 0) *(u32x4*)(KB + (size_t)row * 128 + cl) = w;
                    else { const int b = row >> 12, s = row & (SEQ - 1);
#pragma unroll
                        for (int e = 0; e < 8; ++e) { const int c = cl + e; const float ve = e < 4 ? v0[e & 3] : v1[e & 3];
                            VT[((size_t)(((b * 2 + (c >> 6)) * 32 + (s >> 7)) * 64 + (c & 63))) * 128 + (s & 127)] = f2bf(ve); } }
                }
            }
    }
};

struct EpiHg {
    unsigned char* wsb; const float* rowss; const float* lbl;
    __device__ __forceinline__ void operator()(const f32x4 (&acc)[2][2][4][2], const Unit& u, int wr, int wc, int fr, int fq) const {
        const int sec = u.pn >> 2, b = u.pm >> 4, sb = (u.pm & 15) * BM;
        bf16_t* Tp = (bf16_t*)(wsb + (sec == 3 ? WS_GT : WS_QT + (size_t)sec * (64 * MiB)));
        f32x4 ssall[2][4];
#pragma unroll
        for (int ai = 0; ai < 2; ++ai)
#pragma unroll
            for (int m = 0; m < 4; ++m) ssall[ai][m] = *(const f32x4*)(rowss + u.pm * BM + ai * HALF + wr * 64 + m * 16 + 4 * fq);
        float l0[2][2], l1[2][2];
#pragma unroll
        for (int bj = 0; bj < 2; ++bj)
#pragma unroll
            for (int n = 0; n < 2; ++n) { const int c1 = (u.pn & 3) * BM + bj * HALF + wc * 32 + n * 16 + fr; l0[bj][n] = lbl[c1]; l1[bj][n] = lbl[D + c1]; }
        asm volatile("" ::: "memory");
        float lbv[2][2];
#pragma unroll
        for (int bj = 0; bj < 2; ++bj)
#pragma unroll
            for (int n = 0; n < 2; ++n) lbv[bj][n] = rcpf_(1.f + ex2(LOG2E * (l1[bj][n] - l0[bj][n])));
#pragma unroll
        for (int ai = 0; ai < 2; ++ai)
#pragma unroll
            for (int m = 0; m < 4; ++m) {
                const int rl = ai * HALF + wr * 64 + m * 16 + 4 * fq;
                const f32x4 ssv = ssall[ai][m];
                f32x4 rs; rs[0] = rsqrtf(ssv[0] * (1.f / D) + EPS); rs[1] = rsqrtf(ssv[1] * (1.f / D) + EPS); rs[2] = rsqrtf(ssv[2] * (1.f / D) + EPS); rs[3] = rsqrtf(ssv[3] * (1.f / D) + EPS);
#pragma unroll
                for (int bj = 0; bj < 2; ++bj)
#pragma unroll
                    for (int n = 0; n < 2; ++n) {
                        f32x4 v = acc[ai][bj][m][n] * rs;
                        if (sec == 0) { v[0] = silu_f(v[0]) * 0.08838834764831845f; v[1] = silu_f(v[1]) * 0.08838834764831845f; v[2] = silu_f(v[2]) * 0.08838834764831845f; v[3] = silu_f(v[3]) * 0.08838834764831845f; }
                        else if (sec == 1) { const float lb = lbv[bj][n], om = 1.f - lb;
#pragma unroll
                            for (int e = 0; e < 4; ++e) v[e] = om * sigmoid_f(-v[e]); (void)lb; }
                        else if (sec == 3) { v[0] = silu_f(v[0]); v[1] = silu_f(v[1]); v[2] = silu_f(v[2]); v[3] = silu_f(v[3]); }
                        const int head = 2 * (u.pn & 3) + bj, c = wc * 32 + n * 16 + fr;
                        u32x2 w; w.x = cvt_pk_bf16(v[0], v[1]); w.y = cvt_pk_bf16(v[2], v[3]);
                        { const int sa = sb + rl; bf16_t* cb = Tp + ((size_t)((b * 8 + head) * 128 + (sa >> 5))) * 4096;
                          if (sec == 3) *(u32x2*)(cb + (2 * wc + n) * 512 + (fq * 16 + fr) * 8 + (m & 1) * 4) = w;
                          else *(u32x2*)(cb + c * 32 + (sa & 31)) = w; }
                    }
            }
    }
};

struct EpiFfn {
    bf16_t* U; const float* rowss; const float* cw; const float* cb; LAS float* halo; float* GH; float* GS; float* VS;
    __device__ __forceinline__ void operator()(f32x4 (&acc)[2][2][4][2], const Unit& u, int wr, int wc, int fr, int fq) const {
        const int t0 = (u.pm & 15) * BM, lane = fr + 16 * fq; const bool first = t0 == 0;
        float ssq[8];
#pragma unroll
        for (int i = 0; i < 8; ++i) ssq[i] = rowss[u.pm * BM + (i >> 2) * HALF + wr * 64 + (i & 3) * 16 + fr];
        asm volatile("" ::: "memory");
#pragma unroll
        for (int ai = 0; ai < 2; ++ai)
#pragma unroll
            for (int m = 0; m < 4; ++m) {
                const float rs = rsqrtf(ssq[ai * 4 + m] * (1.f / D) + EPS);
#pragma unroll
                for (int bj = 0; bj < 2; ++bj)
#pragma unroll
                    for (int n = 0; n < 2; ++n) acc[ai][bj][m][n] = acc[ai][bj][m][n] * rs;
            }
        if (fr >= 14) {
#pragma unroll
            for (int ai = 0; ai < 2; ++ai)
#pragma unroll
                for (int n = 0; n < 2; ++n) *(LAS f32x4*)(halo + ((2 * ai + wr) * 2 + (15 - fr)) * 128 + wc * 32 + 8 * fq + 4 * n) = acc[ai][0][3][n];
        }
        WG_BAR();
        u32x2 keep[2][4];
#pragma unroll
        for (int n = 0; n < 2; ++n) {
            const int f0 = u.pn * 128 + wc * 32 + 8 * fq + 4 * n;
            const f32x4 w0 = *(const f32x4*)(cw + f0), w1 = *(const f32x4*)(cw + DFF + f0), w2 = *(const f32x4*)(cw + 2 * DFF + f0), bb = *(const f32x4*)(cb + f0);
#pragma unroll
            for (int ai = 0; ai < 2; ++ai) {
                const int blk = 2 * ai + wr;
                f32x4 h1 = (f32x4){0.f, 0.f, 0.f, 0.f}, h2 = h1;
                if (blk > 0) { h1 = *(const LAS f32x4*)(halo + ((blk - 1) * 2 + 0) * 128 + wc * 32 + 8 * fq + 4 * n); h2 = *(const LAS f32x4*)(halo + ((blk - 1) * 2 + 1) * 128 + wc * 32 + 8 * fq + 4 * n); }
                f32x4 r1p = h1, r2p = h2;
#pragma unroll
                for (int m = 0; m < 4; ++m) {
                    const f32x4 g = acc[ai][0][m][n];
                    f32x4 r1, r2;
#pragma unroll
                    for (int e = 0; e < 4; ++e) { r1[e] = row_ror_f(g[e], 0x121); r2[e] = row_ror_f(g[e], 0x122); }
                    f32x4 p1, p2;
                    if (m == 0) {
#pragma unroll
                        for (int e = 0; e < 4; ++e) { p1[e] = fr >= 1 ? r1[e] : h1[e]; p2[e] = fr >= 2 ? r2[e] : (fr == 1 ? h1[e] : h2[e]); }
                    } else {
#pragma unroll
                        for (int e = 0; e < 4; ++e) { p1[e] = fr >= 1 ? r1[e] : r1p[e]; p2[e] = fr >= 2 ? r2[e] : r2p[e]; }
                    }
                    r1p = r1; r2p = r2;
                    const int rl = ai * HALF + wr * 64 + m * 16 + fr, t = t0 + rl;
                    if (t < 1) p1 = (f32x4){0.f, 0.f, 0.f, 0.f};
                    if (t < 2) p2 = (f32x4){0.f, 0.f, 0.f, 0.f};
                    const f32x4 cv = bb + w0 * p2 + w1 * p1 + w2 * g;
                    const f32x4 vv = acc[ai][1][m][n];
                    f32x4 o; o[0] = silu_f(cv[0]) * vv[0]; o[1] = silu_f(cv[1]) * vv[1]; o[2] = silu_f(cv[2]) * vv[2]; o[3] = silu_f(cv[3]) * vv[3];
                    if (rl >= 2 || first) { u32x2 w; w[0] = cvt_pk_bf16(o[0], o[1]); w[1] = cvt_pk_bf16(o[2], o[3]);
                        if (n == 0) keep[ai][m] = w; else *(u32x4*)(U + (size_t)(u.pm * BM + rl) * DFF + f0 - 4) = (u32x4){keep[ai][m][0], keep[ai][m][1], w[0], w[1]}; }
                    else { *(f32x4*)(GS + (size_t)(u.pm * 2 + rl) * DFF + f0) = g; *(f32x4*)(VS + (size_t)(u.pm * 2 + rl) * DFF + f0) = vv; }
                    if (rl >= 254) *(f32x4*)(GH + (size_t)(u.pm * 2 + rl - 254) * DFF + f0) = g;
                }
            }
        }
    }
};
}

namespace hg {
constexpr int A_WAVE_LDS = 5120;
constexpr int RING = 19456, OTP = 272;
static_assert(8 * A_WAVE_LDS <= 131072, "hgrn lds");

__device__ __forceinline__ void pass_a_chunk(LAS unsigned char* ldsw, int cidx, bf16_t* QT, bf16_t* FT, const bf16_t* IT, float* DC, bf16_t* OI, int lane) {
    const int kl = lane & 15, seg = lane >> 4;
    bf16_t* qc = QT + (size_t)cidx * 4096; bf16_t* fc = FT + (size_t)cidx * 4096; (void)IT;
    float* dc = DC + (size_t)cidx * 256; bf16_t* oi = OI + (size_t)cidx * 1024;
    LAS unsigned char* Qs = ldsw; LAS unsigned char* Ks = ldsw + 2560;
    f32x4 sc[2][2];
#pragma unroll
    for (int a = 0; a < 2; ++a)
#pragma unroll
        for (int b = 0; b < 2; ++b) sc[a][b] = (f32x4){0.f, 0.f, 0.f, 0.f};
    u32x4 qall[8], fall[8];
#pragma unroll
    for (int kg = 0; kg < 8; ++kg) { qall[kg] = *(const u32x4*)(qc + (16 * kg + kl) * 32 + 8 * seg); fall[kg] = *(const u32x4*)(fc + (16 * kg + kl) * 32 + 8 * seg); }
#pragma unroll
    for (int ks = 0; ks < 4; ++ks) {
#pragma unroll
        for (int kgl = 0; kgl < 2; ++kgl) {
            const int kg = 2 * ks + kgl;
            const u32x4 qv4 = qall[kg], fv4 = fall[kg];
            float kk[8], qv[8];
#pragma unroll
            for (int i = 0; i < 4; ++i) { kk[2 * i] = bf_lo(fv4[i]); kk[2 * i + 1] = bf_hi(fv4[i]); qv[2 * i] = bf_lo(qv4[i]); qv[2 * i + 1] = bf_hi(qv4[i]); }
            float pr[8]; float p = 1.f;
#pragma unroll
            for (int j = 0; j < 8; ++j) { p *= (1.f - kk[j]); pr[j] = p; }
            const float t0 = __shfl(p, kl), t1 = __shfl(p, kl + 16), t2 = __shfl(p, kl + 32), t3 = __shfl(p, kl + 48);
            const float offs = (seg > 0 ? t0 : 1.f) * (seg > 1 ? t1 : 1.f) * (seg > 2 ? t2 : 1.f), dC = (t0 * t1) * (t2 * t3);
            float kh[8];
#pragma unroll
            for (int j = 0; j < 8; ++j) { const float e = pr[j] * offs, kt = kk[j] * rcpf_(e); kh[j] = kt * dC;
                *(LAS bf16_t*)(Qs + (8 * seg + j) * 80 + (16 * kgl + kl) * 2) = f2bf(qv[j] * e);
                *(LAS bf16_t*)(Ks + (8 * seg + j) * 80 + (16 * kgl + kl) * 2) = f2bf(kt); }
            u32x4 khp; khp[0] = cvt_pk_bf16(kh[0], kh[1]); khp[1] = cvt_pk_bf16(kh[2], kh[3]); khp[2] = cvt_pk_bf16(kh[4], kh[5]); khp[3] = cvt_pk_bf16(kh[6], kh[7]);
            *(u32x4*)(fc + kg * 512 + lane * 8) = khp;
            if (seg == 0) dc[16 * kg + kl] = dC;
        }
        bf16x8 Af[2], Bf[2];
#pragma unroll
        for (int st = 0; st < 2; ++st) Af[st] = *(const LAS bf16x8*)(Ks + (16 * st + kl) * 80 + 16 * seg);
#pragma unroll
        for (int tt = 0; tt < 2; ++tt) Bf[tt] = *(const LAS bf16x8*)(Qs + (16 * tt + kl) * 80 + 16 * seg);
#pragma unroll
        for (int st = 0; st < 2; ++st)
#pragma unroll
            for (int tt = 0; tt < 2; ++tt) sc[st][tt] = __builtin_amdgcn_mfma_f32_16x16x32_bf16(Af[st], Bf[tt], sc[st][tt], 0, 0, 0);
#pragma unroll
        for (int tt = 0; tt < 2; ++tt) { const u32x2 lo = *(const LAS u32x2*)(Qs + (16 * tt + kl) * 80 + 8 * seg), hi = *(const LAS u32x2*)(Qs + (16 * tt + kl) * 80 + 32 + 8 * seg);
            *(u32x4*)(qc + (2 * ks + tt) * 512 + lane * 8) = (u32x4){lo.x, lo.y, hi.x, hi.y}; }
    }
#pragma unroll
    for (int tt = 0; tt < 2; ++tt) { const int t = 16 * tt + kl;
#pragma unroll
        for (int r = 0; r < 4; ++r) { const unsigned pk = cvt_pk_bf16((4 * seg + r <= t) ? sc[0][tt][r] : 0.f, (16 + 4 * seg + r <= t) ? sc[1][tt][r] : 0.f);
            *(LAS bf16_t*)(Qs + t * 80 + (4 * seg + r) * 2) = (bf16_t)(pk & 0xffffu); *(LAS bf16_t*)(Qs + t * 80 + (16 + 4 * seg + r) * 2) = (bf16_t)(pk >> 16); } }
    asm volatile("" ::: "memory");
#pragma unroll
    for (int tt = 0; tt < 2; ++tt) { const u32x4 pf = *(const LAS u32x4*)(Qs + (16 * tt + kl) * 80 + 16 * seg); *(u32x4*)(oi + tt * 512 + lane * 8) = pf; }
}

constexpr int OFF_PRIV = 3 * RING, OFF_OT = OFF_PRIV + 3 * 8 * 2048, OFF_OS = OFF_OT + 2 * 32 * OTP, B_END = OFF_OS + 2 * 32 * OTP;
static_assert(B_END <= 163840, "hgrn pass B lds");
#define HGB_DMA(c, stg) do { const size_t ce_ = (size_t)(cbase + (c)) * 4096; LAS unsigned char* sh_ = lds + (stg) * RING; LAS unsigned char* pv_ = lds + OFF_PRIV + ((stg) * 8 + w) * 2048; \
        __builtin_amdgcn_global_load_lds((const unsigned*)(QF + ce_ + w * 512 + lane * 8), (LAS unsigned*)(sh_ + w * 1024), 16, 0, 0); \
        __builtin_amdgcn_global_load_lds((const unsigned*)(KH + ce_ + w * 512 + lane * 8), (LAS unsigned*)(sh_ + 8192 + w * 1024), 16, 0, 0); \
        __builtin_amdgcn_global_load_lds((const unsigned*)(DC + (size_t)(cbase + (c)) * 256 + lane * 4), (LAS unsigned*)(sh_ + 16384), 16, 0, 0); \
        __builtin_amdgcn_global_load_lds((const unsigned*)(IT + ce_ + (16 * w + kl) * 32 + 8 * seg), (LAS unsigned*)(pv_), 16, 0, 0); \
        __builtin_amdgcn_global_load_lds((const unsigned*)(OI + (size_t)(cbase + (c)) * 1024 + (w & 1) * 512 + lane * 8), (LAS unsigned*)(sh_ + 17408 + (w & 1) * 1024), 16, 0, 0); \
        __builtin_amdgcn_global_load_lds((const unsigned*)(GT + ce_ + w * 512 + lane * 8), (LAS unsigned*)(pv_ + 1024), 16, 0, 0); } while (0)
#define HGB_OUT(c, par_) do { const int t_ = tid >> 4, cc_ = tid & 15; \
        const u32x4 r_ = *(const LAS u32x4*)(lds + OFF_OS + (par_) * 32 * OTP + t_ * OTP + cc_ * 16); \
        const u32x4 v_ = *(const LAS u32x4*)(lds + OFF_OT + (par_) * 32 * OTP + t_ * OTP + cc_ * 16); \
        float ss_ = 0.f; \
        _Pragma("unroll") for (int i_ = 0; i_ < 4; ++i_) { const float lo_ = bf_lo(r_[i_]), hi_ = bf_hi(r_[i_]); ss_ += lo_ * lo_ + hi_ * hi_; } \
        ss_ += row_ror_f(ss_, 0x128); ss_ += row_ror_f(ss_, 0x124); ss_ += row_ror_f(ss_, 0x122); ss_ += row_ror_f(ss_, 0x121);   \
        const float rs_ = rsqrtf(ss_ * (1.f / 128.f) + EPS); u32x4 o_; \
        _Pragma("unroll") for (int i_ = 0; i_ < 4; ++i_) o_[i_] = cvt_pk_bf16(bf_lo(v_[i_]) * rs_, bf_hi(v_[i_]) * rs_); \
          \
        asm volatile("global_store_dwordx4 %0, %1, off\n\ts_nop 1" :: "v"(AO + (size_t)(b * SEQ + (c) * 32 + t_) * D + h * 128 + cc_ * 8), "v"(o_) : "memory"); } while (0)

__device__ __forceinline__ void pass_b_item(LAS unsigned char* lds, int b, int h, const bf16_t* QF, const bf16_t* KH, const bf16_t* IT, const bf16_t* GT, const float* DC, const bf16_t* OI, bf16_t* AO, unsigned* flag, unsigned want) {
    int tid = threadIdx.x; asm volatile("" : "+v"(tid));
    const int lane = tid & 63, w = __builtin_amdgcn_readfirstlane(tid >> 6), kl = lane & 15, seg = lane >> 4;
    const int cbase = (b * 8 + h) * 128, NCH = SEQ / 32;
    f32x4 S[8];
#pragma unroll
    for (int kg = 0; kg < 8; ++kg) S[kg] = (f32x4){0.f, 0.f, 0.f, 0.f};
    HGB_DMA(0, 0); HGB_DMA(1, 1);
    asm volatile("s_waitcnt vmcnt(0)" ::: "memory"); __builtin_amdgcn_s_barrier(); asm volatile("" ::: "memory");
    int sc = 0, s2 = 2;
    for (int n = 0; n < NCH; ++n) {
        if (n == NCH / 2 - 2) {
            if (tid == 0) { unsigned sp = 0; while (__hip_atomic_load(flag, __ATOMIC_RELAXED, __HIP_MEMORY_SCOPE_AGENT) < want) { __builtin_amdgcn_s_sleep(2); if (++sp > (1u << 22)) break; }
                __builtin_amdgcn_fence(__ATOMIC_ACQUIRE, "agent"); asm volatile("s_waitcnt vmcnt(0)" ::: "memory"); }
            WG_BAR();
        }
        if (n + 2 < NCH) HGB_DMA(n + 2, s2);
        if (n > 0) HGB_OUT(n - 1, (n - 1) & 1);
        const LAS unsigned char* st = lds + sc * RING; const LAS unsigned char* pv = lds + OFF_PRIV + (sc * 8 + w) * 2048 + lane * 16;
        bf16x8 Sb[4];
#pragma unroll
        for (int ks = 0; ks < 4; ++ks) { const u32x4 pk = (u32x4){cvt_pk_bf16(S[2 * ks][0], S[2 * ks][1]), cvt_pk_bf16(S[2 * ks][2], S[2 * ks][3]), cvt_pk_bf16(S[2 * ks + 1][0], S[2 * ks + 1][1]), cvt_pk_bf16(S[2 * ks + 1][2], S[2 * ks + 1][3])}; Sb[ks] = __builtin_bit_cast(bf16x8, pk); }
        const u32x4 Gc = *(const LAS u32x4*)(pv + 1024);
        const bf16x8 pf0 = *(const LAS bf16x8*)(st + 17408 + lane * 16), pf1 = *(const LAS bf16x8*)(st + 17408 + 1024 + lane * 16);
        f32x4 o[2];
        bf16x8 qa[8], ka[8]; f32x4 dcv[8];
#pragma unroll
        for (int i = 0; i < 8; ++i) qa[i] = *(const LAS bf16x8*)(st + i * 1024 + lane * 16);
        const bf16x8 Vb = *(const LAS bf16x8*)(pv);
#pragma unroll
        for (int kg = 0; kg < 8; ++kg) { dcv[kg] = *(const LAS f32x4*)(st + 16384 + (16 * kg + 4 * seg) * 4); ka[kg] = *(const LAS bf16x8*)(st + 8192 + kg * 1024 + lane * 16); }
        __builtin_amdgcn_sched_barrier(0);
        { const f32x4 z = (f32x4){0.f, 0.f, 0.f, 0.f}; o[0] = __builtin_amdgcn_mfma_f32_16x16x32_bf16(pf0, Vb, z, 0, 0, 0); o[1] = __builtin_amdgcn_mfma_f32_16x16x32_bf16(pf1, Vb, z, 0, 0, 0); }
#pragma unroll
        for (int ks = 0; ks < 4; ++ks)
#pragma unroll
            for (int tt = 0; tt < 2; ++tt) o[tt] = __builtin_amdgcn_mfma_f32_16x16x32_bf16(qa[2 * ks + tt], Sb[ks], o[tt], 0, 0, 0);
#pragma unroll
        for (int kg = 0; kg < 8; ++kg) S[kg] = __builtin_amdgcn_mfma_f32_16x16x32_bf16(ka[kg], Vb, S[kg] * dcv[kg], 0, 0, 0);
        const int par = n & 1;
#pragma unroll
        for (int tt = 0; tt < 2; ++tt) { const float gv[4] = {bf_lo(Gc[2 * tt]), bf_hi(Gc[2 * tt]), bf_lo(Gc[2 * tt + 1]), bf_hi(Gc[2 * tt + 1])};
#pragma unroll
            for (int r = 0; r < 4; ++r) { const int t = 16 * tt + 4 * seg + r; const unsigned pk = cvt_pk_bf16(o[tt][r], o[tt][r] * gv[r]);
                *(LAS bf16_t*)(lds + OFF_OS + par * 32 * OTP + t * OTP + (16 * w + kl) * 2) = (bf16_t)(pk & 0xffffu);
                *(LAS bf16_t*)(lds + OFF_OT + par * 32 * OTP + t * OTP + (16 * w + kl) * 2) = (bf16_t)(pk >> 16); } }
        if (n + 2 < NCH) asm volatile("s_waitcnt vmcnt(6)" ::: "memory"); else asm volatile("s_waitcnt vmcnt(0)" ::: "memory");
        WG_BAR();
        sc = sc == 2 ? 0 : sc + 1; s2 = s2 == 2 ? 0 : s2 + 1;
    }
    HGB_OUT(NCH - 1, (NCH - 1) & 1);
    asm volatile("s_waitcnt vmcnt(0)" ::: "memory");
    WG_BAR();
}
}

namespace att {
constexpr int KP = 144, VP = 528, OFF_K = 0, OFF_V = 256 * KP;
static_assert(OFF_V + 64 * VP <= 131072, "attn lds");
__device__ __forceinline__ void attn_item(LAS unsigned char* lds, int b, int kvh, int nb, const bf16_t* QB, const bf16_t* KB, const bf16_t* VT, bf16_t* OB, const float* sinks) {
    int tid = threadIdx.x; asm volatile("" : "+v"(tid));
    const int lane = tid & 63, w = __builtin_amdgcn_readfirstlane(tid >> 6), kl = lane & 15, seg = lane >> 4;
    LAS unsigned char* Kl = lds + OFF_K; LAS unsigned char* Vl = lds + OFF_V;
    const int sbase = 128 * (nb - 1);
#pragma unroll
    for (int i = 0; i < 4; ++i) { const int id = tid + 512 * i, row = id >> 3, cchunk = id & 7, s = sbase + row;
        u32x4 v = (u32x4){0u, 0u, 0u, 0u}; if (s >= 0) v = *(const u32x4*)(KB + (size_t)(b * SEQ + s) * 128 + kvh * 64 + cchunk * 8);
        *(LAS u32x4*)(Kl + row * KP + cchunk * 16) = v; }
#pragma unroll
    for (int i = 0; i < 4; ++i) { const int id = tid + 512 * i, d = id >> 5, cchunk = id & 31, key0 = cchunk * 8, blk = nb - 1 + (key0 >> 7);
        u32x4 v = (u32x4){0u, 0u, 0u, 0u}; if (blk >= 0) v = *(const u32x4*)(VT + ((size_t)(((b * 2 + kvh) * 32 + blk) * 64 + d)) * 128 + (key0 & 127));
        *(LAS u32x4*)(Vl + d * VP + cchunk * 16) = v; }
    WG_BAR();
    const int head = kvh * 8 + w;
    const float slope2 = ex2(-0.5f * (float)(head + 1)) * LOG2E, sink2 = sinks[head] * LOG2E;
    for (int qb = 0; qb < 8; ++qb) {
        const size_t rowq = (size_t)(b * SEQ + nb * 128 + 16 * qb + kl);
        bf16x8 qf[2];
#pragma unroll
        for (int ks = 0; ks < 2; ++ks) qf[ks] = *(const bf16x8*)(QB + rowq * D + head * 64 + 32 * ks + 8 * seg);
        const int kt0 = qb < 6 ? qb : 6;
        f32x4 sc[10];
#pragma unroll
        for (int jt = 0; jt < 10; ++jt) { sc[jt] = (f32x4){0.f, 0.f, 0.f, 0.f};
#pragma unroll
            for (int ks = 0; ks < 2; ++ks) { const bf16x8 a = *(const LAS bf16x8*)(Kl + (16 * (kt0 + jt) + kl) * KP + (32 * ks + 8 * seg) * 2); sc[jt] = __builtin_amdgcn_mfma_f32_16x16x32_bf16(a, qf[ks], sc[jt], 0, 0, 0); } }
        const int iq = 16 * qb + kl, dbase = 128 + iq - 16 * kt0 - 4 * seg; const unsigned dlim = nb > 0 ? 127u : (unsigned)iq;
        float mx = -INFINITY;
#pragma unroll
        for (int jt = 0; jt < 10; ++jt)
#pragma unroll
            for (int r = 0; r < 4; ++r) { const int dist = dbase - (16 * jt + r);
                const float v = ((unsigned)dist <= dlim) ? sc[jt][r] - slope2 * (float)dist : -INFINITY; sc[jt][r] = v; mx = fmaxf(mx, v); }
        mx = fmaxf(mx, __shfl_xor(mx, 16)); mx = fmaxf(mx, __shfl_xor(mx, 32)); mx = fmaxf(mx, sink2);
        float sum = 0.f;
#pragma unroll
        for (int jt = 0; jt < 10; ++jt)
#pragma unroll
            for (int r = 0; r < 4; ++r) { const float e = ex2(sc[jt][r] - mx); sc[jt][r] = e; sum += e; }
        sum += __shfl_xor(sum, 16); sum += __shfl_xor(sum, 32);
        const float inv = 1.f / (sum + ex2(sink2 - mx));
        bf16x8 pB[5];
#pragma unroll
        for (int kb = 0; kb < 5; ++kb) { u32x4 pk; pk[0] = cvt_pk_bf16(sc[2 * kb][0], sc[2 * kb][1]); pk[1] = cvt_pk_bf16(sc[2 * kb][2], sc[2 * kb][3]); pk[2] = cvt_pk_bf16(sc[2 * kb + 1][0], sc[2 * kb + 1][1]); pk[3] = cvt_pk_bf16(sc[2 * kb + 1][2], sc[2 * kb + 1][3]);
            pB[kb] = __builtin_bit_cast(bf16x8, pk); }
#pragma unroll
        for (int dt = 0; dt < 4; ++dt) {
            f32x4 o = (f32x4){0.f, 0.f, 0.f, 0.f};
#pragma unroll
            for (int kb = 0; kb < 5; ++kb) { const LAS unsigned char* vp = Vl + (16 * dt + kl) * VP + (16 * (kt0 + 2 * kb) + 4 * seg) * 2;
                const u32x2 lo = *(const LAS u32x2*)(vp), hi = *(const LAS u32x2*)(vp + 32);
                const u32x4 av = (u32x4){lo.x, lo.y, hi.x, hi.y};
                o = __builtin_amdgcn_mfma_f32_16x16x32_bf16(__builtin_bit_cast(bf16x8, av), pB[kb], o, 0, 0, 0); }
            u32x2 wv; wv.x = cvt_pk_bf16(o[0] * inv, o[1] * inv); wv.y = cvt_pk_bf16(o[2] * inv, o[3] * inv);
            *(u32x2*)(OB + rowq * D + head * 64 + 16 * dt + 4 * seg) = wv;
        }
    }
    WG_BAR();
}
}

__device__ __forceinline__ float wave_sum(float v) {
#pragma unroll
    for (int o = 1; o < 64; o <<= 1) v += __shfl_xor(v, o);
    return v;
}
__device__ __forceinline__ void transpose_item(const float* W, int K, int N, bf16_t* WT, int row_off, int mode, const float* gain, int gmask, float scale, LAS float* scr, int item, int lane) {
    const int nblk = N / 32, kb = item / nblk, nb = item % nblk, k0 = 64 * kb, n0 = 32 * nb;
#pragma unroll 8
    for (int i = 0; i < 32; ++i) { const int kk = 2 * i + (lane >> 5); const float gsc = gain ? gain[(k0 + kk) & gmask] * scale : scale; scr[kk * 33 + (lane & 31)] = W[(size_t)(k0 + kk) * N + n0 + (lane & 31)] * gsc; }
    LDS_WAIT(); asm volatile("" ::: "memory");
    const int c = lane & 7;
#pragma unroll
    for (int j = 0; j < 4; ++j) { const int nl = (lane >> 3) + 8 * j, n = n0 + nl; const LAS float* s = scr + (8 * c) * 33 + nl;
        u32x4 o; o.x = cvt_pk_bf16(s[0 * 33], s[1 * 33]); o.y = cvt_pk_bf16(s[2 * 33], s[3 * 33]); o.z = cvt_pk_bf16(s[4 * 33], s[5 * 33]); o.w = cvt_pk_bf16(s[6 * 33], s[7 * 33]);
        int drow; if (mode == 0) drow = row_off + n; else { const int isv = n >= DFF ? 1 : 0, f = n - isv * DFF; drow = 256 * (f >> 7) + 128 * isv + (f & 127); }
        *(u32x4*)(WT + (size_t)drow * K + k0 + 8 * c) = o; }
    LDS_WAIT(); asm volatile("" ::: "memory");
}


#define XB_TMO      128
#define XB_XCNT(j)  (256  + 64 * (j))
#define XB_XSUB(j)  (1280 + 64 * (j))
#define XB_XGEN(j)  (2304 + 64 * (j))
#define XB_TOP      3328
#define XB_TOPGEN   3392
#define XCD_BAR_WORDS 3456
#define XB_SPIN_CAP (1u << 18)
__device__ __forceinline__ unsigned xb_ld(unsigned* p)              { return __hip_atomic_load(p, __ATOMIC_RELAXED, __HIP_MEMORY_SCOPE_AGENT); }
__device__ __forceinline__ unsigned xb_add(unsigned* p, unsigned v) { return __hip_atomic_fetch_add(p, v, __ATOMIC_RELAXED, __HIP_MEMORY_SCOPE_AGENT); }
__device__ __forceinline__ unsigned xb_xcc_id() { return (unsigned)__builtin_amdgcn_s_getreg((3 << 11) | 20) & 0xFu; }
#define XB_SPIN(cond, bar) do { unsigned _sp = 0; while (cond) { __builtin_amdgcn_s_sleep(1); \
    if ((++_sp & 255u) == 0u) { if (xb_ld(&(bar)[XB_TMO])) break; if (_sp > XB_SPIN_CAP) { atomicAdd(&(bar)[XB_TMO], 1u); break; } } } } while (0)
struct XcdBarrier { unsigned* bar; unsigned x; volatile LAS unsigned* st; };
__device__ __forceinline__ XcdBarrier xcd_barrier_post(unsigned* bar, volatile LAS unsigned* st) {
    XcdBarrier b; b.bar = bar; b.x = xb_xcc_id(); b.st = st;
    if (threadIdx.x == 0) (void)xb_add(&bar[XB_XCNT(b.x)], 1u);
    return b;
}
__device__ __forceinline__ void xcd_barrier_complete(unsigned* bar, unsigned x, unsigned& nloc, unsigned& nx) {
    const unsigned G = gridDim.x * gridDim.y * gridDim.z;
    unsigned sum, cnt, mine, sp = 0u;
    for (;;) {
        sum = 0u; cnt = 0u; mine = 0u;
#pragma unroll
        for (unsigned j = 0; j < 16; ++j) { const unsigned c = xb_ld(&bar[XB_XCNT(j)]); sum += c; cnt += (c > 0u) ? 1u : 0u; mine = (j == x) ? c : mine; }
        if (sum == G) break;
        __builtin_amdgcn_s_sleep(1);
        if ((++sp & 255u) == 0u) { if (xb_ld(&bar[XB_TMO])) break; if (sp > XB_SPIN_CAP) { atomicAdd(&bar[XB_TMO], 1u); break; } }
    }
    nloc = mine > 0u ? mine : 1u; nx = cnt > 0u ? cnt : 1u;
}
__device__ __forceinline__ void xcd_barrier(const XcdBarrier& b) {
    asm volatile("s_waitcnt vmcnt(0)" ::: "memory");
    __syncthreads();
    if (threadIdx.x == 0) {
        unsigned* bar = b.bar;
        __builtin_amdgcn_s_waitcnt(0);
        unsigned nloc = b.st[0], nx = b.st[1];
        if (nloc == 0u) { xcd_barrier_complete(bar, b.x, nloc, nx); b.st[0] = nloc; b.st[1] = nx; }
        const unsigned old = xb_add(&bar[XB_XSUB(b.x)], 1u);
        const unsigned gen = old / nloc;
        if (old + 1u == (gen + 1u) * nloc) {
            __builtin_amdgcn_fence(__ATOMIC_RELEASE, "agent");
            asm volatile("s_waitcnt vmcnt(0)" ::: "memory");
            const unsigned og = xb_add(&bar[XB_TOP], 1u);
            const unsigned tg = og / nx;
            if (og + 1u == (tg + 1u) * nx) xb_add(&bar[XB_TOPGEN], 1u);
            else XB_SPIN(xb_ld(&bar[XB_TOPGEN]) == tg, bar);
            __builtin_amdgcn_fence(__ATOMIC_ACQUIRE, "agent");
            xb_add(&bar[XB_XGEN(b.x)], 1u);
            asm volatile("s_waitcnt vmcnt(0)" ::: "memory");
        } else {
            XB_SPIN(xb_ld(&bar[XB_XGEN(b.x)]) == gen, bar);
            __builtin_amdgcn_fence(__ATOMIC_ACQUIRE, "agent");
            asm volatile("s_waitcnt vmcnt(0)" ::: "memory");
        }
    }
    __syncthreads();
}


__device__ __forceinline__ void ffn_fixup(const pg8::StaticOrder& S, bf16_t* Uo, const float* GH, const float* GS, const float* VS, const float* cw, const float* cb) {
    pg8::Unit u;
    for (int i = 0; S.next(i, u); ++i) {
        const int pm = u.pm; if ((pm & 15) == 0) continue;
#pragma unroll
        for (int it = 0; it < 2; ++it) {
            const int q = (int)threadIdx.x + 512 * it;
            if (q < DFF / 4) {
                const int f = 4 * q;
                const f32x4 g254 = *(const f32x4*)(GH + (size_t)((pm - 1) * 2 + 0) * DFF + f), g255 = *(const f32x4*)(GH + (size_t)((pm - 1) * 2 + 1) * DFF + f);
                const f32x4 g0 = *(const f32x4*)(GS + (size_t)(pm * 2 + 0) * DFF + f), g1 = *(const f32x4*)(GS + (size_t)(pm * 2 + 1) * DFF + f);
                const f32x4 v0 = *(const f32x4*)(VS + (size_t)(pm * 2 + 0) * DFF + f), v1 = *(const f32x4*)(VS + (size_t)(pm * 2 + 1) * DFF + f);
                const f32x4 w0 = *(const f32x4*)(cw + f), w1 = *(const f32x4*)(cw + DFF + f), w2 = *(const f32x4*)(cw + 2 * DFF + f), bb = *(const f32x4*)(cb + f);
                const f32x4 c0 = bb + w0 * g254 + w1 * g255 + w2 * g0, c1 = bb + w0 * g255 + w1 * g0 + w2 * g1;
                u32x2 o0, o1;
                o0[0] = cvt_pk_bf16(silu_f(c0[0]) * v0[0], silu_f(c0[1]) * v0[1]); o0[1] = cvt_pk_bf16(silu_f(c0[2]) * v0[2], silu_f(c0[3]) * v0[3]);
                o1[0] = cvt_pk_bf16(silu_f(c1[0]) * v1[0], silu_f(c1[1]) * v1[1]); o1[1] = cvt_pk_bf16(silu_f(c1[2]) * v1[2], silu_f(c1[3]) * v1[3]);
                *(u32x2*)(Uo + (size_t)(pm * 256 + 0) * DFF + f) = o0; *(u32x2*)(Uo + (size_t)(pm * 256 + 1) * DFF + f) = o1;
            }
        }
    }
    asm volatile("s_waitcnt vmcnt(0)" ::: "memory");
    __syncthreads();
}

struct Params {
    const float* in[18];
    float* out; unsigned char* ws;
};

constexpr int LDS_HALO_OFF = 131072;
constexpr int LDS_BYTES = 163840;
constexpr int LDS_XB_OFF = 163328;

__global__ void __launch_bounds__(512, 2) yoco_fwd(Params P) {
    extern __shared__ __attribute__((aligned(16))) unsigned char lds_raw[];
    LAS unsigned char* lds = (LAS unsigned char*)lds_raw;
    cg::grid_group grid = cg::this_grid();
    const int tid = threadIdx.x, lane = tid & 63, wave = __builtin_amdgcn_readfirstlane(tid >> 6);
    const int G = gridDim.x, bx = blockIdx.x;
#define x ((const float*)P.in[0])
#define hg_norm ((const float*)P.in[1])
#define hg_w_in ((const float*)P.in[2])
#define hg_lb ((const float*)P.in[3])
#define hg_out_norm ((const float*)P.in[4])
#define hg_w_out ((const float*)P.in[5])
#define kv_norm ((const float*)P.in[6])
#define w_kv ((const float*)P.in[7])
#define attn_norm ((const float*)P.in[8])
#define attn_w_q ((const float*)P.in[9])
#define attn_sinks ((const float*)P.in[10])
#define attn_w_o ((const float*)P.in[11])
#define ffn_norm ((const float*)P.in[12])
#define ffn_w_up ((const float*)P.in[13])
#define ffn_conv_w ((const float*)P.in[14])
#define ffn_conv_b ((const float*)P.in[15])
#define ffn_w_down ((const float*)P.in[16])
#define final_norm ((const float*)P.in[17])
#define RS ((float*)(P.ws + WS_RS))
#define WinT ((bf16_t*)(P.ws + WS_WIN))
#define WoutT ((bf16_t*)(P.ws + WS_WOUT))
#define WupT0 ((bf16_t*)(P.ws + WS_WUP0))
#define WdT0 ((bf16_t*)(P.ws + WS_WD0))
#define WqkvT ((bf16_t*)(P.ws + WS_WQKV))
#define WoT ((bf16_t*)(P.ws + WS_WO))
#define WupT1 ((bf16_t*)(P.ws + WS_WUP1))
#define WdT1 ((bf16_t*)(P.ws + WS_WD1))
#define HB ((bf16_t*)(P.ws + WS_HB))
#define H ((float*)(P.ws + WS_H))
#define QT ((bf16_t*)(P.ws + WS_QT))
#define FT ((bf16_t*)(P.ws + WS_FT))
#define IT ((bf16_t*)(P.ws + WS_IT))
#define GT ((bf16_t*)(P.ws + WS_GT))
#define AO ((bf16_t*)(P.ws + WS_AO))
#define OI ((bf16_t*)(P.ws + WS_OI))
#define DC ((float*)(P.ws + WS_DC))
#define U ((bf16_t*)(P.ws + WS_U))
#define QB ((bf16_t*)(P.ws + WS_QB))
#define KB ((bf16_t*)(P.ws + WS_KB))
#define VT ((bf16_t*)(P.ws + WS_VT))
#define OB ((bf16_t*)(P.ws + WS_OB))
#define FGH ((float*)(P.ws + WS_H))
#define FGS ((float*)(P.ws + WS_H + 4 * MiB))
#define FVS ((float*)(P.ws + WS_H + 8 * MiB))
    const int gw = bx * 8 + wave, NGW = G * 8;

    {
        LAS float* scr = (LAS float*)(lds + wave * 16384);
        for (int it = gw; it < 16 * 128; it += NGW) transpose_item(hg_w_in, D, 4 * D, WinT, 0, 0, hg_norm, 1023, 1.f, scr, it, lane);
        for (int m = gw; m < M; m += NGW) {
            const f32x4* xr = (const f32x4*)(x + (size_t)m * D) + lane; float s = 0.f;
            unsigned long long* o8 = (unsigned long long*)(HB + (size_t)m * D) + lane;
#pragma unroll
            for (int j = 0; j < 4; ++j) { const f32x4 v = xr[64 * j]; s += (v[0] * v[0] + v[1] * v[1]) + (v[2] * v[2] + v[3] * v[3]);
                o8[64 * j] = (unsigned long long)cvt_pk_bf16(v[0], v[1]) | ((unsigned long long)cvt_pk_bf16(v[2], v[3]) << 32); }
            s = wave_sum(s);
            if (lane == 0) RS[m] = s;
        }
        for (int i = bx * 512 + tid; i < 4 * M; i += G * 512) RS[M + i] = 0.f;
        if (bx == 0) for (int i = tid; i < XCD_BAR_WORDS; i += 512) ((unsigned*)(P.ws + WS_BAR))[i] = 0u;
        if (tid < 2) ((LAS unsigned*)(lds + LDS_XB_OFF))[tid] = 0u;
    }
    grid.sync();
    const XcdBarrier xbar = xcd_barrier_post((unsigned*)(P.ws + WS_BAR), (volatile LAS unsigned*)(lds + LDS_XB_OFF));

    {
        pg8::Gemm g{HB, WinT, M, 4 * D, D}; pg8::StaticOrder S; S.init(M / 256, 16, G, bx, 0);
        pg8::EpiHg E{P.ws, RS, hg_lb};
        pg8::gemm_phase<pg8::EpiHg, true>(lds, g, S, E);
    }
    xcd_barrier(xbar);

    for (int c = gw; c < 4096; c += NGW) hg::pass_a_chunk(lds + wave * hg::A_WAVE_LDS, (c & 63) * 128 + (c >> 6), QT, FT, IT, DC, OI, lane);
    xcd_barrier(xbar);
    unsigned* hgflag = (unsigned*)(P.ws + WS_BAR) + 3424;
    if (bx < 64) { for (int item = bx; item < 64; item += G) hg::pass_b_item(lds, item >> 3, item & 7, QT, FT, IT, GT, DC, OI, AO, hgflag, (unsigned)(G - 64)); }
    else {
        for (int c = (bx - 64) * 8 + wave; c < 4096; c += (G - 64) * 8) hg::pass_a_chunk(lds + wave * hg::A_WAVE_LDS, (c & 63) * 128 + 64 + (c >> 6), QT, FT, IT, DC, OI, lane);
        asm volatile("s_waitcnt vmcnt(0)" ::: "memory"); __syncthreads();
        if (tid == 0) { __builtin_amdgcn_fence(__ATOMIC_RELEASE, "agent"); asm volatile("s_waitcnt vmcnt(0)" ::: "memory"); __hip_atomic_fetch_add(hgflag, 1u, __ATOMIC_RELAXED, __HIP_MEMORY_SCOPE_AGENT); }
        LAS float* scr = (LAS float*)(lds + wave * 16384);
        constexpr int I_SQ = 16 * 32, I_UP = 16 * 176, I_DN = 44 * 32, I_KV = 16 * 8;
        constexpr int NIT = I_SQ + 2 * I_UP + 2 * I_DN + I_SQ + I_KV + I_SQ;
        for (int it = (bx - 64) * 8 + wave; it < NIT; it += (G - 64) * 8) {
            int r = it;
            if (r < I_SQ) { transpose_item(hg_w_out, D, D, WoutT, 0, 0, hg_out_norm, 127, 1.f, scr, r, lane); continue; } r -= I_SQ;
            if (r < I_UP) { transpose_item(ffn_w_up, D, 2 * DFF, WupT0, 0, 1, ffn_norm, 1023, 1.f, scr, r, lane); continue; } r -= I_UP;
            if (r < I_UP) { transpose_item(ffn_w_up + (size_t)D * 2 * DFF, D, 2 * DFF, WupT1, 0, 1, ffn_norm + D, 1023, 1.f, scr, r, lane); continue; } r -= I_UP;
            if (r < I_DN) { transpose_item(ffn_w_down, DFF, D, WdT0, 0, 0, nullptr, 0, 1.f, scr, r, lane); continue; } r -= I_DN;
            if (r < I_DN) { transpose_item(ffn_w_down + (size_t)DFF * D, DFF, D, WdT1, 0, 0, nullptr, 0, 1.f, scr, r, lane); continue; } r -= I_DN;
            if (r < I_SQ) { transpose_item(attn_w_q, D, D, WqkvT, 0, 0, attn_norm, 1023, 0.125f * LOG2E, scr, r, lane); continue; } r -= I_SQ;
            if (r < I_KV) { transpose_item(w_kv, D, 256, WqkvT, 1024, 0, kv_norm, 1023, 1.f, scr, r, lane); continue; } r -= I_KV;
            transpose_item(attn_w_o, D, D, WoT, 0, 0, nullptr, 0, 1.f, scr, r, lane);
        }
    }
    xcd_barrier(xbar);

    {
        pg8::Gemm g{AO, WoutT, M, D, D}; pg8::StaticOrder S; S.init(M / 256, 4, G, bx, 0);
        pg8::EpiRes E{HB, RS + M};
        pg8::gemm_phase<pg8::EpiRes, false, true>(lds, g, S, E);
    }
    xcd_barrier(xbar);

#define FFN_LAYER(layer) do { \
        { pg8::Gemm g{HB, layer == 0 ? WupT0 : WupT1, M, 2 * DFF, D}; pg8::StaticOrder S; S.init(M / 256, 22, G, bx, 0); \
          pg8::EpiFfn E{U, RS + (layer == 0 ? 1 : 3) * M, ffn_conv_w + (size_t)layer * 3 * DFF, ffn_conv_b + (size_t)layer * DFF, (LAS float*)(lds + LDS_HALO_OFF), FGH, FGS, FVS}; \
          pg8::gemm_phase<pg8::EpiFfn, false, true>(lds, g, S, E); } \
        xcd_barrier(xbar); \
        { pg8::Gemm g{U, layer == 0 ? WdT0 : WdT1, M, D, DFF}; pg8::StaticOrder S; S.init(M / 256, 4, G, bx, 0); \
          ffn_fixup(S, U, FGH, FGS, FVS, ffn_conv_w + (size_t)layer * 3 * DFF, ffn_conv_b + (size_t)layer * DFF); \
          pg8::EpiRes E{HB, RS + (layer == 0 ? 2 : 4) * M}; \
          pg8::gemm_phase<pg8::EpiRes, false, true>(lds, g, S, E); } \
        xcd_barrier(xbar); } while (0)

    FFN_LAYER(0);
    {
        pg8::Gemm g{HB, WqkvT, M, 1280, D}; pg8::StaticOrder S; S.init(M / 256, 5, G, bx, 0);
        pg8::EpiQkv E{QB, KB, VT, RS + 2 * M};
        pg8::gemm_phase<pg8::EpiQkv, false, true>(lds, g, S, E);
    }
    xcd_barrier(xbar);
    for (int item = bx; item < 512; item += G) { const int nb = item & 31, kvh = (item >> 5) & 1, b = item >> 6; att::attn_item(lds, b, kvh, nb, QB, KB, VT, OB, attn_sinks); }
    xcd_barrier(xbar);
    {
        pg8::Gemm g{OB, WoT, M, D, D}; pg8::StaticOrder S; S.init(M / 256, 4, G, bx, 0);
        pg8::EpiRes E{HB, RS + 3 * M};
        pg8::gemm_phase<pg8::EpiRes, false, true>(lds, g, S, E);
    }
    xcd_barrier(xbar);
    FFN_LAYER(1);

    for (int m = gw; m < M; m += NGW) {
        const float rs = rsqrtf(RS[4 * M + m] * (1.f / D) + EPS);
        const u32x2* hrow = (const u32x2*)(HB + (size_t)m * D) + lane; f32x4* orow = (f32x4*)(P.out + (size_t)m * D) + lane; const f32x4* gn = (const f32x4*)final_norm + lane;
#pragma unroll
        for (int j = 0; j < 4; ++j) { const u32x2 hv = hrow[64 * j]; const f32x4 v = (f32x4){bf_lo(hv[0]), bf_hi(hv[0]), bf_lo(hv[1]), bf_hi(hv[1])}; orow[64 * j] = v * rs * gn[64 * j]; }
    }
}

extern "C" void kernel_launch(void* const* d_in, const int* in_sizes, int n_in, void* d_out, int out_size, void* d_ws, size_t ws_size, hipStream_t stream) {
    static int grid_blocks = 0;
    if (grid_blocks == 0) {
        if (n_in != 18 || in_sizes[0] != M * D || out_size != M * D || ws_size < WS_END) { fprintf(stderr, "kernel_launch: unexpected shapes (n_in %d, in0 %d, out %d, ws %zu)\n", n_in, n_in > 0 ? in_sizes[0] : -1, out_size, ws_size); grid_blocks = -1; return; }
        int dev = 0, cus = 0, per_cu = 0;
        hipGetDevice(&dev);
        hipDeviceGetAttribute(&cus, hipDeviceAttributeMultiprocessorCount, dev);
        hipFuncSetAttribute((const void*)yoco_fwd, hipFuncAttributeMaxDynamicSharedMemorySize, LDS_BYTES);
        hipOccupancyMaxActiveBlocksPerMultiprocessor(&per_cu, (const void*)yoco_fwd, 512, LDS_BYTES);
        if (per_cu < 1) { fprintf(stderr, "kernel_launch: occupancy query says %d blocks per CU\n", per_cu); grid_blocks = -1; return; }
        grid_blocks = cus;
    }
    if (grid_blocks < 0) return;
    Params p{};
    for (int i = 0; i < 18; ++i) p.in[i] = (const float*)d_in[i];
    p.out = (float*)d_out; p.ws = (unsigned char*)d_ws;
    void* args[] = {&p};
    hipError_t e = hipLaunchCooperativeKernel((const void*)yoco_fwd, dim3(grid_blocks), dim3(512), args, LDS_BYTES, stream);
    if (e != hipSuccess) fprintf(stderr, "cooperative launch failed: %s (grid %d)\n", hipGetErrorString(e), grid_blocks);
}
```

```cpp
#include <hip/hip_runtime.h>
#include <hip/hip_cooperative_groups.h>
#include <cstdio>
#include <cstdint>
namespace cg = cooperative_groups;

#define LAS __attribute__((address_space(3)))
typedef unsigned short bf16_t;
typedef short bf16x8 __attribute__((ext_vector_type(8)));
typedef short s16x4 __attribute__((ext_vector_type(4)));
typedef float f32x4 __attribute__((ext_vector_type(4)));
typedef unsigned u32x4 __attribute__((ext_vector_type(4)));
typedef unsigned u32x2 __attribute__((ext_vector_type(2)));

constexpr int D = 1024, BATCH = 8, SEQ = 4096, M = BATCH * SEQ, DFF = 2816;
constexpr float EPS = 1e-6f;
constexpr float LOG2E = 1.4426950408889634f;

constexpr size_t MiB = 1u << 20;
constexpr size_t WS_RS = 0;
constexpr size_t WS_BAR = 768 * 1024;
constexpr size_t WS_WIN = 1 * MiB, WS_WOUT = 9 * MiB, WS_WUP0 = 11 * MiB, WS_WD0 = 22 * MiB, WS_WQKV = 28 * MiB, WS_WO = 31 * MiB, WS_WUP1 = 33 * MiB, WS_WD1 = 44 * MiB;
constexpr size_t WS_HB = 51 * MiB;
constexpr size_t WS_H = 116 * MiB;
constexpr size_t WS_T = 244 * MiB;
constexpr size_t WS_QT = WS_T, WS_FT = WS_T + 64 * MiB, WS_IT = WS_T + 128 * MiB, WS_AO = WS_T + 192 * MiB, WS_GT = WS_H, WS_OI = WS_H + 64 * MiB, WS_DC = WS_T + 256 * MiB;
constexpr size_t WS_U = WS_T;
constexpr size_t WS_QB = WS_T, WS_KB = WS_T + 64 * MiB, WS_VT = WS_T + 72 * MiB, WS_OB = WS_T + 80 * MiB;
constexpr size_t WS_END = 512 * MiB;

typedef float f32x2_t __attribute__((ext_vector_type(2))); typedef __bf16 bf16x2_t __attribute__((ext_vector_type(2)));
__device__ __forceinline__ unsigned cvt_pk_bf16(float lo, float hi) { const f32x2_t v = {lo, hi}; const bf16x2_t r = __builtin_convertvector(v, bf16x2_t); return __builtin_bit_cast(unsigned, r); }
__device__ __forceinline__ bf16_t f2bf(float f) { return (bf16_t)(cvt_pk_bf16(f, 0.f) & 0xffffu); }
__device__ __forceinline__ float bf_lo(unsigned u) { return __uint_as_float(u << 16); }
__device__ __forceinline__ float bf_hi(unsigned u) { return __uint_as_float(u & 0xffff0000u); }
__device__ __forceinline__ float ex2(float x) { return __builtin_amdgcn_exp2f(x); }
__device__ __forceinline__ float rcpf_(float x) { return __builtin_amdgcn_rcpf(x); }
__device__ __forceinline__ float sigmoid_f(float v) { return rcpf_(1.f + ex2(-LOG2E * v)); }
__device__ __forceinline__ float silu_f(float v) { return v * sigmoid_f(v); }
template <int CTRL> __device__ __forceinline__ float row_ror_t(float v) { return __builtin_bit_cast(float, __builtin_amdgcn_update_dpp(0, __builtin_bit_cast(int, v), CTRL, 0xf, 0xf, false)); }
#define row_ror_f(v, ctrl) row_ror_t<ctrl>(v)
#define LDS_WAIT() asm volatile("s_waitcnt lgkmcnt(0)" ::: "memory")
#define WG_BAR() do { asm volatile("s_waitcnt lgkmcnt(0)" ::: "memory"); __builtin_amdgcn_s_barrier(); asm volatile("" ::: "memory"); } while (0)

namespace pg8 {
constexpr int BM = 256, BK = 64, HALF = 128, HTB = HALF * BK * 2, STAGE_BYTES = 8 * HTB, NXCD = 8, WGM = 8;
__host__ __device__ __forceinline__ int lds_byte(int r, int c) { const int st = (r >> 4) * 2 + (c >> 5), rr = r & 15, cc = c & 31, ob = rr * 64 + cc * 2; return st * 1024 + (ob ^ (((ob >> 9) & 1) << 5)); }
__host__ __device__ __forceinline__ int perm32(int rho) { const int n = rho >> 4, i = rho & 15; return 8 * (i >> 2) + 4 * n + (i & 3); }
__host__ __device__ __forceinline__ void stage_rc(int b, int& R, int& C) { const int st = b / 1024, sb = b % 1024, swz = sb ^ (((sb >> 9) & 1) << 5); R = (st >> 1) * 16 + swz / 64; C = (st & 1) * 32 + (swz % 64) / 2; }

struct Unit { int pm, pn, arow; };
struct Gemm { const bf16_t* A; const bf16_t* Bt; int M, N, K; };

struct StaticOrder {
    int nM, nN, nwg, G, c, ovl;
    __device__ void init(int nM_, int nN_, int G_, int c_, int ovl_) { nM = nM_; nN = nN_; nwg = nM * nN; G = G_; c = c_; ovl = ovl_; }
    __device__ bool next(int i, Unit& u) const {
        const long L = (long)i * G + c; if (L >= nwg) return false;
        int wgid = (int)L; { const int q = nwg / NXCD, r = nwg % NXCD, xcd = wgid % NXCD, off = wgid / NXCD; wgid = (xcd < r ? xcd * (q + 1) : r * (q + 1) + (xcd - r) * q) + off; }
        const int nig = WGM * nN, gid = wgid / nig, fm = gid * WGM, gsz = (nM - fm) < WGM ? (nM - fm) : WGM;
        u.pm = fm + ((wgid % nig) % gsz); u.pn = (wgid % nig) / gsz;
        u.arow = ovl ? (u.pm / 17) * SEQ + 254 * (u.pm % 17) - 2 : u.pm * BM;
        return true;
    }
};

template <class Epi, bool SWAP, bool PERM = false>
__device__ __forceinline__ void gemm_phase(LAS unsigned char* lds, const Gemm g, const StaticOrder& S, const Epi& E) {
    int tid = threadIdx.x; asm volatile("" : "+v"(tid));
    const int wid = __builtin_amdgcn_readfirstlane(tid >> 6), lane = tid & 63, wr = wid >> 2, wc = wid & 3, fr = lane & 15, fq = lane >> 4;
    const int K = g.K, nt = K / BK;
    unsigned voffA[2], voffB[2];
#pragma unroll
    for (int i = 0; i < 2; ++i) { int R, C; stage_rc(tid * 16 + i * 8192, R, C); voffA[i] = (unsigned)(R * K + C) * 2u; const int Rb = PERM ? ((R & ~31) + perm32(R & 31)) : R; voffB[i] = (unsigned)(Rb * K + C) * 2u; }
    const size_t kstep = (size_t)(BK * 2);
    const size_t hstep = (size_t)HALF * K * 2;
    const size_t tstep = 2 * hstep;
    const long rowb = (long)K * 2;
    const unsigned ldsw = (unsigned)wid * 1024u;
    const int aoff = lds_byte(wr * 64 + fr, fq * 8), boff = lds_byte(wc * 32 + fr, fq * 8);
#define PG8_SA(b, h) (((b) * 2 + (h)) * HTB)
#define PG8_SB(b, h) ((4 + (b) * 2 + (h)) * HTB)
#define PG8_STAGE(bufoff, gbase, voff) do { _Pragma("unroll") for (int _i = 0; _i < 2; ++_i) \
        __builtin_amdgcn_global_load_lds((const unsigned*)((const char*)(gbase) + (voff)[_i]), (LAS unsigned*)(lds + (bufoff) + ldsw + _i * 8192), 16, 0, 0); } while (0)
#define PG8_LDA(dst, b, h) do { _Pragma("unroll") for (int m = 0; m < 4; ++m) _Pragma("unroll") for (int k = 0; k < 2; ++k) dst[m][k] = *(const LAS bf16x8*)(lds + PG8_SA(b, h) + aoff + m * 2048 + k * 1024); } while (0)
#define PG8_LDB(dst, b, h) do { _Pragma("unroll") for (int n = 0; n < 2; ++n) _Pragma("unroll") for (int k = 0; k < 2; ++k) dst[n][k] = *(const LAS bf16x8*)(lds + PG8_SB(b, h) + boff + n * 2048 + k * 1024); } while (0)
#define PG8_MMA(ai, bj, At, Bt) do { __builtin_amdgcn_s_setprio(1); _Pragma("unroll") for (int m = 0; m < 4; ++m) _Pragma("unroll") for (int n = 0; n < 2; ++n) _Pragma("unroll") for (int k = 0; k < 2; ++k) { \
        if constexpr (SWAP) acc[ai][bj][m][n] = __builtin_amdgcn_mfma_f32_16x16x32_bf16(At[m][k], Bt[n][k], acc[ai][bj][m][n], 0, 0, 0); \
        else acc[ai][bj][m][n] = __builtin_amdgcn_mfma_f32_16x16x32_bf16(Bt[n][k], At[m][k], acc[ai][bj][m][n], 0, 0, 0); } __builtin_amdgcn_s_setprio(0); } while (0)
#define PG8_WAIT_V(n) asm volatile("s_waitcnt vmcnt(" #n ")" ::: "memory")
#define PG8_WAIT_L(n) asm volatile("s_waitcnt lgkmcnt(" #n ")" ::: "memory")
#define PG8_WAIT_V8R(r) asm volatile("s_cmp_eq_u32 %0, 0\n\ts_cbranch_scc0 1\n\ts_waitcnt vmcnt(8)\n\ts_waitcnt vmcnt(24)" :: "s"(r) : "memory", "scc")
#define PG8_BAR __builtin_amdgcn_s_barrier()
#define PG8_SCHED __builtin_amdgcn_sched_barrier(0)
    Unit cur, nxt; int ui = 0;
    if (!S.next(0, cur)) return;
    f32x4 acc[2][2][4][2];
#pragma unroll
    for (int a = 0; a < 2; ++a)
#pragma unroll
        for (int b = 0; b < 2; ++b)
#pragma unroll
            for (int m = 0; m < 4; ++m)
#pragma unroll
                for (int n = 0; n < 2; ++n) acc[a][b][m][n] = (f32x4){0.f, 0.f, 0.f, 0.f};
    bf16x8 At[4][2], B0[2][2], B1[2][2];
    const char* cA = (const char*)g.A + (long)cur.arow * rowb; const char* cB = (const char*)g.Bt + (size_t)cur.pn * tstep;
    PG8_STAGE(PG8_SB(0, 0), cB, voffB); PG8_STAGE(PG8_SB(0, 1), cB + hstep, voffB); PG8_STAGE(PG8_SA(0, 0), cA, voffA); PG8_STAGE(PG8_SA(0, 1), cA + hstep, voffA);
    if (wr == 1) PG8_BAR;
    PG8_WAIT_V(2); PG8_BAR;
    PG8_STAGE(PG8_SB(1, 0), cB + kstep, voffB); PG8_STAGE(PG8_SA(1, 0), cA + kstep, voffA); PG8_STAGE(PG8_SB(1, 1), cB + hstep + kstep, voffB);
    PG8_WAIT_V(6); PG8_BAR;
    for (;;) {
        const bool has_next = S.next(ui + 1, nxt);
        const char* nA = has_next ? (const char*)g.A + (long)nxt.arow * rowb : cA; const char* nB = has_next ? (const char*)g.Bt + (size_t)nxt.pn * tstep : cB;
        for (int t = 0; t < nt; t += 2) {
            const bool last = (t == nt - 2);
            const char* a1 = cA + (size_t)(t + 1) * kstep;
            const char* a2 = last ? nA : cA + (size_t)(t + 2) * kstep; const char* b2 = last ? nB : cB + (size_t)(t + 2) * kstep;
            const char* a3 = a2 + kstep; const char* b3 = b2 + kstep;
            const int relax = __builtin_amdgcn_readfirstlane(((t == 0) && (ui > 0)) ? 1 : 0);
            PG8_LDB(B0, 0, 0); PG8_LDB(B1, 0, 1); PG8_SCHED; PG8_LDA(At, 0, 0); PG8_STAGE(PG8_SA(1, 1), a1 + hstep, voffA);
            PG8_WAIT_V8R(relax); PG8_WAIT_L(0); PG8_BAR; PG8_MMA(0, 0, At, B0); PG8_MMA(0, 1, At, B1); PG8_BAR; PG8_SCHED;
            PG8_LDA(At, 0, 1); PG8_STAGE(PG8_SB(0, 0), b2, voffB); PG8_STAGE(PG8_SB(0, 1), b2 + hstep, voffB); PG8_STAGE(PG8_SA(0, 0), a2, voffA);
            PG8_WAIT_V8R(relax); PG8_WAIT_L(0); PG8_BAR; PG8_MMA(1, 0, At, B0); PG8_MMA(1, 1, At, B1); PG8_BAR; PG8_SCHED;
            PG8_LDB(B0, 1, 0); PG8_LDB(B1, 1, 1); PG8_SCHED; PG8_LDA(At, 1, 0); PG8_STAGE(PG8_SA(0, 1), a2 + hstep, voffA);
            PG8_WAIT_V(8); PG8_WAIT_L(0); PG8_BAR; PG8_MMA(0, 0, At, B0); PG8_MMA(0, 1, At, B1); PG8_BAR; PG8_SCHED;
            PG8_LDA(At, 1, 1); PG8_STAGE(PG8_SB(1, 0), b3, voffB); PG8_STAGE(PG8_SB(1, 1), b3 + hstep, voffB); PG8_STAGE(PG8_SA(1, 0), a3, voffA);
            PG8_WAIT_V(8); PG8_WAIT_L(0); PG8_BAR; PG8_MMA(1, 0, At, B0); PG8_MMA(1, 1, At, B1); PG8_BAR; PG8_SCHED;
        }
        if (wr == 0) PG8_BAR;
        E(acc, cur, wr, wc, fr, fq);
        if (!has_next) break;
#pragma unroll
        for (int a = 0; a < 2; ++a)
#pragma unroll
            for (int b = 0; b < 2; ++b)
#pragma unroll
                for (int m = 0; m < 4; ++m)
#pragma unroll
                    for (int n = 0; n < 2; ++n) acc[a][b][m][n] = (f32x4){0.f, 0.f, 0.f, 0.f};
        cur = nxt; cA = nA; cB = nB; ++ui;
        if (wr == 1) PG8_BAR;
    }
    PG8_WAIT_V(0);
    PG8_BAR;
#undef PG8_SA
#undef PG8_SB
#undef PG8_STAGE
#undef PG8_LDA
#undef PG8_LDB
#undef PG8_MMA
#undef PG8_WAIT_V
#undef PG8_WAIT_L
#undef PG8_WAIT_V8R
#undef PG8_BAR
#undef PG8_SCHED
}


struct EpiRes {
    bf16_t* hb; float* rowss;
    __device__ __forceinline__ void operator()(const f32x4 (&acc)[2][2][4][2], const Unit& u, int wr, int wc, int fr, int fq) const {
#pragma unroll
        for (int ai = 0; ai < 2; ++ai)
#pragma unroll
            for (int m = 0; m < 4; ++m) {
                const int row = u.pm * BM + ai * HALF + wr * 64 + m * 16 + fr; float ss = 0.f;
#pragma unroll
                for (int bj = 0; bj < 2; ++bj) {
                    const size_t off = (size_t)row * D + u.pn * BM + bj * HALF + wc * 32 + 8 * fq;
                    const u32x4 hv = *(const u32x4*)(hb + off);
                    f32x4 v0 = acc[ai][bj][m][0], v1 = acc[ai][bj][m][1];
                    v0[0] += bf_lo(hv[0]); v0[1] += bf_hi(hv[0]); v0[2] += bf_lo(hv[1]); v0[3] += bf_hi(hv[1]);
                    v1[0] += bf_lo(hv[2]); v1[1] += bf_hi(hv[2]); v1[2] += bf_lo(hv[3]); v1[3] += bf_hi(hv[3]);
                    *(u32x4*)(hb + off) = (u32x4){cvt_pk_bf16(v0[0], v0[1]), cvt_pk_bf16(v0[2], v0[3]), cvt_pk_bf16(v1[0], v1[1]), cvt_pk_bf16(v1[2], v1[3])};
                    ss += ((v0[0] * v0[0] + v0[1] * v0[1]) + (v0[2] * v0[2] + v0[3] * v0[3])) + ((v1[0] * v1[0] + v1[1] * v1[1]) + (v1[2] * v1[2] + v1[3] * v1[3]));
                }
                ss += __shfl_xor(ss, 16); ss += __shfl_xor(ss, 32);
                if (fq == 0) unsafeAtomicAdd(rowss + row, ss);
                asm volatile("" ::: "memory");
            }
    }
};

struct EpiQkv {
    bf16_t* QB; bf16_t* KB; bf16_t* VT; const float* rowss;
    __device__ __forceinline__ void operator()(const f32x4 (&acc)[2][2][4][2], const Unit& u, int wr, int wc, int fr, int fq) const {
#pragma unroll
        for (int ai = 0; ai < 2; ++ai)
#pragma unroll
            for (int m = 0; m < 4; ++m) {
                const int row = u.pm * BM + ai * HALF + wr * 64 + m * 16 + fr;
                const float rs = rsqrtf(rowss[row] * (1.f / D) + EPS);
#pragma unroll
                for (int bj = 0; bj < 2; ++bj) {
                    const f32x4 v0 = acc[ai][bj][m][0] * rs, v1 = acc[ai][bj][m][1] * rs; const int cl = wc * 32 + 8 * fq;
                    const u32x4 w = (u32x4){cvt_pk_bf16(v0[0], v0[1]), cvt_pk_bf16(v0[2], v0[3]), cvt_pk_bf16(v1[0], v1[1]), cvt_pk_bf16(v1[2], v1[3])};
                    if (u.pn < 4) *(u32x4*)(QB + (size_t)row * D + u.pn * BM + bj * HALF + cl) = w;
                    else if (bj == 0) *(u32x4*)(KB + (size_t)row * 128 + cl) = w;
                    else { const int b = row >> 12, s = row & (SEQ - 1);
#pragma unroll
                        for (int e = 0; e < 8; ++e) { const int c = cl + e; const float ve = e < 4 ? v0[e & 3] : v1[e & 3];
                            VT[((size_t)(((b * 2 + (c >> 6)) * 32 + (s >> 7)) * 64 + (c & 63))) * 128 + (s & 127)] = f2bf(ve); } }
                }
            }
    }
};

struct EpiHg {
    unsigned char* wsb; const float* rowss; const float* lbl;
    __device__ __forceinline__ void operator()(const f32x4 (&acc)[2][2][4][2], const Unit& u, int wr, int wc, int fr, int fq) const {
        const int sec = u.pn >> 2, b = u.pm >> 4, sb = (u.pm & 15) * BM;
        bf16_t* Tp = (bf16_t*)(wsb + (sec == 3 ? WS_GT : WS_QT + (size_t)sec * (64 * MiB)));
        f32x4 ssall[2][4];
#pragma unroll
        for (int ai = 0; ai < 2; ++ai)
#pragma unroll
            for (int m = 0; m < 4; ++m) ssall[ai][m] = *(const f32x4*)(rowss + u.pm * BM + ai * HALF + wr * 64 + m * 16 + 4 * fq);
        float l0[2][2], l1[2][2];
#pragma unroll
        for (int bj = 0; bj < 2; ++bj)
#pragma unroll
            for (int n = 0; n < 2; ++n) { const int c1 = (u.pn & 3) * BM + bj * HALF + wc * 32 + n * 16 + fr; l0[bj][n] = lbl[c1]; l1[bj][n] = lbl[D + c1]; }
        asm volatile("" ::: "memory");
        float lbv[2][2];
#pragma unroll
        for (int bj = 0; bj < 2; ++bj)
#pragma unroll
            for (int n = 0; n < 2; ++n) lbv[bj][n] = rcpf_(1.f + ex2(LOG2E * (l1[bj][n] - l0[bj][n])));
#pragma unroll
        for (int ai = 0; ai < 2; ++ai)
#pragma unroll
            for (int m = 0; m < 4; ++m) {
                const int rl = ai * HALF + wr * 64 + m * 16 + 4 * fq;
                const f32x4 ssv = ssall[ai][m];
                f32x4 rs; rs[0] = rsqrtf(ssv[0] * (1.f / D) + EPS); rs[1] = rsqrtf(ssv[1] * (1.f / D) + EPS); rs[2] = rsqrtf(ssv[2] * (1.f / D) + EPS); rs[3] = rsqrtf(ssv[3] * (1.f / D) + EPS);
#pragma unroll
                for (int bj = 0; bj < 2; ++bj)
#pragma unroll
                    for (int n = 0; n < 2; ++n) {
                        f32x4 v = acc[ai][bj][m][n] * rs;
                        if (sec == 0) { v[0] = silu_f(v[0]) * 0.08838834764831845f; v[1] = silu_f(v[1]) * 0.08838834764831845f; v[2] = silu_f(v[2]) * 0.08838834764831845f; v[3] = silu_f(v[3]) * 0.08838834764831845f; }
                        else if (sec == 1) { const float lb = lbv[bj][n], om = 1.f - lb;
#pragma unroll
                            for (int e = 0; e < 4; ++e) v[e] = om * sigmoid_f(-v[e]); (void)lb; }
                        else if (sec == 3) { v[0] = silu_f(v[0]); v[1] = silu_f(v[1]); v[2] = silu_f(v[2]); v[3] = silu_f(v[3]); }
                        const int head = 2 * (u.pn & 3) + bj, c = wc * 32 + n * 16 + fr;
                        u32x2 w; w.x = cvt_pk_bf16(v[0], v[1]); w.y = cvt_pk_bf16(v[2], v[3]);
                        { const int sa = sb + rl; bf16_t* cb = Tp + ((size_t)((b * 8 + head) * 128 + (sa >> 5))) * 4096;
                          if (sec == 3) *(u32x2*)(cb + (2 * wc + n) * 512 + (fq * 16 + fr) * 8 + (m & 1) * 4) = w;
                          else *(u32x2*)(cb + c * 32 + (sa & 31)) = w; }
                    }
            }
    }
};

struct EpiFfn {
    bf16_t* U; const float* rowss; const float* cw; const float* cb; LAS float* halo; float* GH; float* GS; float* VS;
    __device__ __forceinline__ void operator()(f32x4 (&acc)[2][2][4][2], const Unit& u, int wr, int wc, int fr, int fq) const {
        const int t0 = (u.pm & 15) * BM, lane = fr + 16 * fq; const bool first = t0 == 0;
#pragma unroll
        for (int ai = 0; ai < 2; ++ai)
#pragma unroll
            for (int m = 0; m < 4; ++m) {
                const float rs = rsqrtf(rowss[u.pm * BM + ai * HALF + wr * 64 + m * 16 + fr] * (1.f / D) + EPS);
#pragma unroll
                for (int bj = 0; bj < 2; ++bj)
#pragma unroll
                    for (int n = 0; n < 2; ++n) acc[ai][bj][m][n] = acc[ai][bj][m][n] * rs;
            }
        if (fr >= 14) {
#pragma unroll
            for (int ai = 0; ai < 2; ++ai)
#pragma unroll
                for (int n = 0; n < 2; ++n) *(LAS f32x4*)(halo + ((2 * ai + wr) * 2 + (15 - fr)) * 128 + wc * 32 + 8 * fq + 4 * n) = acc[ai][0][3][n];
        }
        WG_BAR();
        u32x2 keep[2][4];
#pragma unroll
        for (int n = 0; n < 2; ++n) {
            const int f0 = u.pn * 128 + wc * 32 + 8 * fq + 4 * n;
            const f32x4 w0 = *(const f32x4*)(cw + f0), w1 = *(const f32x4*)(cw + DFF + f0), w2 = *(const f32x4*)(cw + 2 * DFF + f0), bb = *(const f32x4*)(cb + f0);
#pragma unroll
            for (int ai = 0; ai < 2; ++ai) {
                const int blk = 2 * ai + wr;
                f32x4 h1 = (f32x4){0.f, 0.f, 0.f, 0.f}, h2 = h1;
                if (blk > 0) { h1 = *(const LAS f32x4*)(halo + ((blk - 1) * 2 + 0) * 128 + wc * 32 + 8 * fq + 4 * n); h2 = *(const LAS f32x4*)(halo + ((blk - 1) * 2 + 1) * 128 + wc * 32 + 8 * fq + 4 * n); }
                f32x4 r1p = h1, r2p = h2;
#pragma unroll
                for (int m = 0; m < 4; ++m) {
                    const f32x4 g = acc[ai][0][m][n];
                    f32x4 r1, r2;
#pragma unroll
                    for (int e = 0; e < 4; ++e) { r1[e] = row_ror_f(g[e], 0x121); r2[e] = row_ror_f(g[e], 0x122); }
                    f32x4 p1, p2;
                    if (m == 0) {
#pragma unroll
                        for (int e = 0; e < 4; ++e) { p1[e] = fr >= 1 ? r1[e] : h1[e]; p2[e] = fr >= 2 ? r2[e] : (fr == 1 ? h1[e] : h2[e]); }
                    } else {
#pragma unroll
                        for (int e = 0; e < 4; ++e) { p1[e] = fr >= 1 ? r1[e] : r1p[e]; p2[e] = fr >= 2 ? r2[e] : r2p[e]; }
                    }
                    r1p = r1; r2p = r2;
                    const int rl = ai * HALF + wr * 64 + m * 16 + fr, t = t0 + rl;
                    if (t < 1) p1 = (f32x4){0.f, 0.f, 0.f, 0.f};
                    if (t < 2) p2 = (f32x4){0.f, 0.f, 0.f, 0.f};
                    const f32x4 cv = bb + w0 * p2 + w1 * p1 + w2 * g;
                    const f32x4 vv = acc[ai][1][m][n];
                    f32x4 o; o[0] = silu_f(cv[0]) * vv[0]; o[1] = silu_f(cv[1]) * vv[1]; o[2] = silu_f(cv[2]) * vv[2]; o[3] = silu_f(cv[3]) * vv[3];
                    if (rl >= 2 || first) { u32x2 w; w[0] = cvt_pk_bf16(o[0], o[1]); w[1] = cvt_pk_bf16(o[2], o[3]);
                        if (n == 0) keep[ai][m] = w; else *(u32x4*)(U + (size_t)(u.pm * BM + rl) * DFF + f0 - 4) = (u32x4){keep[ai][m][0], keep[ai][m][1], w[0], w[1]}; }
                    else { *(f32x4*)(GS + (size_t)(u.pm * 2 + rl) * DFF + f0) = g; *(f32x4*)(VS + (size_t)(u.pm * 2 + rl) * DFF + f0) = vv; }
                    if (rl >= 254) *(f32x4*)(GH + (size_t)(u.pm * 2 + rl - 254) * DFF + f0) = g;
                }
            }
        }
    }
};
}

namespace hg {
constexpr int A_WAVE_LDS = 5120;
constexpr int RING = 19456, OTP = 272;
static_assert(8 * A_WAVE_LDS <= 131072, "hgrn lds");

__device__ __forceinline__ void pass_a_chunk(LAS unsigned char* ldsw, int cidx, bf16_t* QT, bf16_t* FT, const bf16_t* IT, float* DC, bf16_t* OI, int lane) {
    const int kl = lane & 15, seg = lane >> 4;
    bf16_t* qc = QT + (size_t)cidx * 4096; bf16_t* fc = FT + (size_t)cidx * 4096; (void)IT;
    float* dc = DC + (size_t)cidx * 256; bf16_t* oi = OI + (size_t)cidx * 1024;
    LAS unsigned char* Qs = ldsw; LAS unsigned char* Ks = ldsw + 2560;
    f32x4 sc[2][2];
#pragma unroll
    for (int a = 0; a < 2; ++a)
#pragma unroll
        for (int b = 0; b < 2; ++b) sc[a][b] = (f32x4){0.f, 0.f, 0.f, 0.f};
    u32x4 qall[8], fall[8];
#pragma unroll
    for (int kg = 0; kg < 8; ++kg) { qall[kg] = *(const u32x4*)(qc + (16 * kg + kl) * 32 + 8 * seg); fall[kg] = *(const u32x4*)(fc + (16 * kg + kl) * 32 + 8 * seg); }
#pragma unroll
    for (int ks = 0; ks < 4; ++ks) {
#pragma unroll
        for (int kgl = 0; kgl < 2; ++kgl) {
            const int kg = 2 * ks + kgl;
            const u32x4 qv4 = qall[kg], fv4 = fall[kg];
            float kk[8], qv[8];
#pragma unroll
            for (int i = 0; i < 4; ++i) { kk[2 * i] = bf_lo(fv4[i]); kk[2 * i + 1] = bf_hi(fv4[i]); qv[2 * i] = bf_lo(qv4[i]); qv[2 * i + 1] = bf_hi(qv4[i]); }
            float pr[8]; float p = 1.f;
#pragma unroll
            for (int j = 0; j < 8; ++j) { p *= (1.f - kk[j]); pr[j] = p; }
            const float t0 = __shfl(p, kl), t1 = __shfl(p, kl + 16), t2 = __shfl(p, kl + 32), t3 = __shfl(p, kl + 48);
            const float offs = (seg > 0 ? t0 : 1.f) * (seg > 1 ? t1 : 1.f) * (seg > 2 ? t2 : 1.f), dC = (t0 * t1) * (t2 * t3);
            float kh[8];
#pragma unroll
            for (int j = 0; j < 8; ++j) { const float e = pr[j] * offs, kt = kk[j] * rcpf_(e); kh[j] = kt * dC;
                *(LAS bf16_t*)(Qs + (8 * seg + j) * 80 + (16 * kgl + kl) * 2) = f2bf(qv[j] * e);
                *(LAS bf16_t*)(Ks + (8 * seg + j) * 80 + (16 * kgl + kl) * 2) = f2bf(kt); }
            u32x4 khp; khp[0] = cvt_pk_bf16(kh[0], kh[1]); khp[1] = cvt_pk_bf16(kh[2], kh[3]); khp[2] = cvt_pk_bf16(kh[4], kh[5]); khp[3] = cvt_pk_bf16(kh[6], kh[7]);
            *(u32x4*)(fc + kg * 512 + lane * 8) = khp;
            if (seg == 0) dc[16 * kg + kl] = dC;
        }
        bf16x8 Af[2], Bf[2];
#pragma unroll
        for (int st = 0; st < 2; ++st) Af[st] = *(const LAS bf16x8*)(Ks + (16 * st + kl) * 80 + 16 * seg);
#pragma unroll
        for (int tt = 0; tt < 2; ++tt) Bf[tt] = *(const LAS bf16x8*)(Qs + (16 * tt + kl) * 80 + 16 * seg);
#pragma unroll
        for (int st = 0; st < 2; ++st)
#pragma unroll
            for (int tt = 0; tt < 2; ++tt) sc[st][tt] = __builtin_amdgcn_mfma_f32_16x16x32_bf16(Af[st], Bf[tt], sc[st][tt], 0, 0, 0);
#pragma unroll
        for (int tt = 0; tt < 2; ++tt) { const u32x2 lo = *(const LAS u32x2*)(Qs + (16 * tt + kl) * 80 + 8 * seg), hi = *(const LAS u32x2*)(Qs + (16 * tt + kl) * 80 + 32 + 8 * seg);
            *(u32x4*)(qc + (2 * ks + tt) * 512 + lane * 8) = (u32x4){lo.x, lo.y, hi.x, hi.y}; }
    }
#pragma unroll
    for (int tt = 0; tt < 2; ++tt) { const int t = 16 * tt + kl;
#pragma unroll
        for (int r = 0; r < 4; ++r) { const unsigned pk = cvt_pk_bf16((4 * seg + r <= t) ? sc[0][tt][r] : 0.f, (16 + 4 * seg + r <= t) ? sc[1][tt][r] : 0.f);
            *(LAS bf16_t*)(Qs + t * 80 + (4 * seg + r) * 2) = (bf16_t)(pk & 0xffffu); *(LAS bf16_t*)(Qs + t * 80 + (16 + 4 * seg + r) * 2) = (bf16_t)(pk >> 16); } }
    asm volatile("" ::: "memory");
#pragma unroll
    for (int tt = 0; tt < 2; ++tt) { const u32x4 pf = *(const LAS u32x4*)(Qs + (16 * tt + kl) * 80 + 16 * seg); *(u32x4*)(oi + tt * 512 + lane * 8) = pf; }
}

constexpr int OFF_PRIV = 3 * RING, OFF_OT = OFF_PRIV + 3 * 8 * 2048, OFF_OS = OFF_OT + 2 * 32 * OTP, B_END = OFF_OS + 2 * 32 * OTP;
static_assert(B_END <= 163840, "hgrn pass B lds");
#define HGB_DMA(c, stg) do { const size_t ce_ = (size_t)(cbase + (c)) * 4096; LAS unsigned char* sh_ = lds + (stg) * RING; LAS unsigned char* pv_ = lds + OFF_PRIV + ((stg) * 8 + w) * 2048; \
        __builtin_amdgcn_global_load_lds((const unsigned*)(QF + ce_ + w * 512 + lane * 8), (LAS unsigned*)(sh_ + w * 1024), 16, 0, 0); \
        __builtin_amdgcn_global_load_lds((const unsigned*)(KH + ce_ + w * 512 + lane * 8), (LAS unsigned*)(sh_ + 8192 + w * 1024), 16, 0, 0); \
        __builtin_amdgcn_global_load_lds((const unsigned*)(DC + (size_t)(cbase + (c)) * 256 + lane * 4), (LAS unsigned*)(sh_ + 16384), 16, 0, 0); \
        __builtin_amdgcn_global_load_lds((const unsigned*)(IT + ce_ + (16 * w + kl) * 32 + 8 * seg), (LAS unsigned*)(pv_), 16, 0, 0); \
        __builtin_amdgcn_global_load_lds((const unsigned*)(OI + (size_t)(cbase + (c)) * 1024 + (w & 1) * 512 + lane * 8), (LAS unsigned*)(sh_ + 17408 + (w & 1) * 1024), 16, 0, 0); \
        __builtin_amdgcn_global_load_lds((const unsigned*)(GT + ce_ + w * 512 + lane * 8), (LAS unsigned*)(pv_ + 1024), 16, 0, 0); } while (0)
#define HGB_OUT(c, par_) do { const int t_ = tid >> 4, cc_ = tid & 15; \
        const u32x4 r_ = *(const LAS u32x4*)(lds + OFF_OS + (par_) * 32 * OTP + t_ * OTP + cc_ * 16); \
        const u32x4 v_ = *(const LAS u32x4*)(lds + OFF_OT + (par_) * 32 * OTP + t_ * OTP + cc_ * 16); \
        float ss_ = 0.f; \
        _Pragma("unroll") for (int i_ = 0; i_ < 4; ++i_) { const float lo_ = bf_lo(r_[i_]), hi_ = bf_hi(r_[i_]); ss_ += lo_ * lo_ + hi_ * hi_; } \
        ss_ += row_ror_f(ss_, 0x128); ss_ += row_ror_f(ss_, 0x124); ss_ += row_ror_f(ss_, 0x122); ss_ += row_ror_f(ss_, 0x121);   \
        const float rs_ = rsqrtf(ss_ * (1.f / 128.f) + EPS); u32x4 o_; \
        _Pragma("unroll") for (int i_ = 0; i_ < 4; ++i_) o_[i_] = cvt_pk_bf16(bf_lo(v_[i_]) * rs_, bf_hi(v_[i_]) * rs_); \
          \
        asm volatile("global_store_dwordx4 %0, %1, off\n\ts_nop 1" :: "v"(AO + (size_t)(b * SEQ + (c) * 32 + t_) * D + h * 128 + cc_ * 8), "v"(o_) : "memory"); } while (0)

__device__ __forceinline__ void pass_b_item(LAS unsigned char* lds, int b, int h, const bf16_t* QF, const bf16_t* KH, const bf16_t* IT, const bf16_t* GT, const float* DC, const bf16_t* OI, bf16_t* AO, unsigned* flag, unsigned want) {
    int tid = threadIdx.x; asm volatile("" : "+v"(tid));
    const int lane = tid & 63, w = __builtin_amdgcn_readfirstlane(tid >> 6), kl = lane & 15, seg = lane >> 4;
    const int cbase = (b * 8 + h) * 128, NCH = SEQ / 32;
    f32x4 S[8];
#pragma unroll
    for (int kg = 0; kg < 8; ++kg) S[kg] = (f32x4){0.f, 0.f, 0.f, 0.f};
    HGB_DMA(0, 0); HGB_DMA(1, 1);
    asm volatile("s_waitcnt vmcnt(0)" ::: "memory"); __builtin_amdgcn_s_barrier(); asm volatile("" ::: "memory");
    int sc = 0, s2 = 2;
    for (int n = 0; n < NCH; ++n) {
        if (n == NCH / 2 - 2) {
            if (tid == 0) { unsigned sp = 0; while (__hip_atomic_load(flag, __ATOMIC_RELAXED, __HIP_MEMORY_SCOPE_AGENT) < want) { __builtin_amdgcn_s_sleep(2); if (++sp > (1u << 22)) break; }
                __builtin_amdgcn_fence(__ATOMIC_ACQUIRE, "agent"); asm volatile("s_waitcnt vmcnt(0)" ::: "memory"); }
            WG_BAR();
        }
        if (n + 2 < NCH) HGB_DMA(n + 2, s2);
        if (n > 0) HGB_OUT(n - 1, (n - 1) & 1);
        const LAS unsigned char* st = lds + sc * RING; const LAS unsigned char* pv = lds + OFF_PRIV + (sc * 8 + w) * 2048 + lane * 16;
        bf16x8 Sb[4];
#pragma unroll
        for (int ks = 0; ks < 4; ++ks) { const u32x4 pk = (u32x4){cvt_pk_bf16(S[2 * ks][0], S[2 * ks][1]), cvt_pk_bf16(S[2 * ks][2], S[2 * ks][3]), cvt_pk_bf16(S[2 * ks + 1][0], S[2 * ks + 1][1]), cvt_pk_bf16(S[2 * ks + 1][2], S[2 * ks + 1][3])}; Sb[ks] = __builtin_bit_cast(bf16x8, pk); }
        const u32x4 Gc = *(const LAS u32x4*)(pv + 1024);
        const bf16x8 pf0 = *(const LAS bf16x8*)(st + 17408 + lane * 16), pf1 = *(const LAS bf16x8*)(st + 17408 + 1024 + lane * 16);
        f32x4 o[2];
        bf16x8 qa[8], ka[8]; f32x4 dcv[8];
#pragma unroll
        for (int i = 0; i < 8; ++i) qa[i] = *(const LAS bf16x8*)(st + i * 1024 + lane * 16);
        const bf16x8 Vb = *(const LAS bf16x8*)(pv);
#pragma unroll
        for (int kg = 0; kg < 8; ++kg) { dcv[kg] = *(const LAS f32x4*)(st + 16384 + (16 * kg + 4 * seg) * 4); ka[kg] = *(const LAS bf16x8*)(st + 8192 + kg * 1024 + lane * 16); }
        __builtin_amdgcn_sched_barrier(0);
        { const f32x4 z = (f32x4){0.f, 0.f, 0.f, 0.f}; o[0] = __builtin_amdgcn_mfma_f32_16x16x32_bf16(pf0, Vb, z, 0, 0, 0); o[1] = __builtin_amdgcn_mfma_f32_16x16x32_bf16(pf1, Vb, z, 0, 0, 0); }
#pragma unroll
        for (int ks = 0; ks < 4; ++ks)
#pragma unroll
            for (int tt = 0; tt < 2; ++tt) o[tt] = __builtin_amdgcn_mfma_f32_16x16x32_bf16(qa[2 * ks + tt], Sb[ks], o[tt], 0, 0, 0);
#pragma unroll
        for (int kg = 0; kg < 8; ++kg) S[kg] = __builtin_amdgcn_mfma_f32_16x16x32_bf16(ka[kg], Vb, S[kg] * dcv[kg], 0, 0, 0);
        const int par = n & 1;
#pragma unroll
        for (int tt = 0; tt < 2; ++tt) { const float gv[4] = {bf_lo(Gc[2 * tt]), bf_hi(Gc[2 * tt]), bf_lo(Gc[2 * tt + 1]), bf_hi(Gc[2 * tt + 1])};
#pragma unroll
            for (int r = 0; r < 4; ++r) { const int t = 16 * tt + 4 * seg + r; const unsigned pk = cvt_pk_bf16(o[tt][r], o[tt][r] * gv[r]);
                *(LAS bf16_t*)(lds + OFF_OS + par * 32 * OTP + t * OTP + (16 * w + kl) * 2) = (bf16_t)(pk & 0xffffu);
                *(LAS bf16_t*)(lds + OFF_OT + par * 32 * OTP + t * OTP + (16 * w + kl) * 2) = (bf16_t)(pk >> 16); } }
        if (n + 2 < NCH) asm volatile("s_waitcnt vmcnt(6)" ::: "memory"); else asm volatile("s_waitcnt vmcnt(0)" ::: "memory");
        WG_BAR();
        sc = sc == 2 ? 0 : sc + 1; s2 = s2 == 2 ? 0 : s2 + 1;
    }
    HGB_OUT(NCH - 1, (NCH - 1) & 1);
    asm volatile("s_waitcnt vmcnt(0)" ::: "memory");
    WG_BAR();
}
}

namespace att {
constexpr int KP = 144, VP = 528, OFF_K = 0, OFF_V = 256 * KP;
static_assert(OFF_V + 64 * VP <= 131072, "attn lds");
__device__ __forceinline__ void attn_item(LAS unsigned char* lds, int b, int kvh, int nb, const bf16_t* QB, const bf16_t* KB, const bf16_t* VT, bf16_t* OB, const float* sinks) {
    int tid = threadIdx.x; asm volatile("" : "+v"(tid));
    const int lane = tid & 63, w = __builtin_amdgcn_readfirstlane(tid >> 6), kl = lane & 15, seg = lane >> 4;
    LAS unsigned char* Kl = lds + OFF_K; LAS unsigned char* Vl = lds + OFF_V;
    const int sbase = 128 * (nb - 1);
#pragma unroll
    for (int i = 0; i < 4; ++i) { const int id = tid + 512 * i, row = id >> 3, cchunk = id & 7, s = sbase + row;
        u32x4 v = (u32x4){0u, 0u, 0u, 0u}; if (s >= 0) v = *(const u32x4*)(KB + (size_t)(b * SEQ + s) * 128 + kvh * 64 + cchunk * 8);
        *(LAS u32x4*)(Kl + row * KP + cchunk * 16) = v; }
#pragma unroll
    for (int i = 0; i < 4; ++i) { const int id = tid + 512 * i, d = id >> 5, cchunk = id & 31, key0 = cchunk * 8, blk = nb - 1 + (key0 >> 7);
        u32x4 v = (u32x4){0u, 0u, 0u, 0u}; if (blk >= 0) v = *(const u32x4*)(VT + ((size_t)(((b * 2 + kvh) * 32 + blk) * 64 + d)) * 128 + (key0 & 127));
        *(LAS u32x4*)(Vl + d * VP + cchunk * 16) = v; }
    WG_BAR();
    const int head = kvh * 8 + w;
    const float slope2 = ex2(-0.5f * (float)(head + 1)) * LOG2E, sink2 = sinks[head] * LOG2E;
    for (int qb = 0; qb < 8; ++qb) {
        const size_t rowq = (size_t)(b * SEQ + nb * 128 + 16 * qb + kl);
        bf16x8 qf[2];
#pragma unroll
        for (int ks = 0; ks < 2; ++ks) qf[ks] = *(const bf16x8*)(QB + rowq * D + head * 64 + 32 * ks + 8 * seg);
        const int kt0 = qb < 6 ? qb : 6;
        f32x4 sc[10];
#pragma unroll
        for (int jt = 0; jt < 10; ++jt) { sc[jt] = (f32x4){0.f, 0.f, 0.f, 0.f};
#pragma unroll
            for (int ks = 0; ks < 2; ++ks) { const bf16x8 a = *(const LAS bf16x8*)(Kl + (16 * (kt0 + jt) + kl) * KP + (32 * ks + 8 * seg) * 2); sc[jt] = __builtin_amdgcn_mfma_f32_16x16x32_bf16(a, qf[ks], sc[jt], 0, 0, 0); } }
        const int iq = 16 * qb + kl, dbase = 128 + iq - 16 * kt0 - 4 * seg; const unsigned dlim = nb > 0 ? 127u : (unsigned)iq;
        float mx = -INFINITY;
#pragma unroll
        for (int jt = 0; jt < 10; ++jt)
#pragma unroll
            for (int r = 0; r < 4; ++r) { const int dist = dbase - (16 * jt + r);
                const float v = ((unsigned)dist <= dlim) ? sc[jt][r] - slope2 * (float)dist : -INFINITY; sc[jt][r] = v; mx = fmaxf(mx, v); }
        mx = fmaxf(mx, __shfl_xor(mx, 16)); mx = fmaxf(mx, __shfl_xor(mx, 32)); mx = fmaxf(mx, sink2);
        float sum = 0.f;
#pragma unroll
        for (int jt = 0; jt < 10; ++jt)
#pragma unroll
            for (int r = 0; r < 4; ++r) { const float e = ex2(sc[jt][r] - mx); sc[jt][r] = e; sum += e; }
        sum += __shfl_xor(sum, 16); sum += __shfl_xor(sum, 32);
        const float inv = 1.f / (sum + ex2(sink2 - mx));
        bf16x8 pB[5];
#pragma unroll
        for (int kb = 0; kb < 5; ++kb) { u32x4 pk; pk[0] = cvt_pk_bf16(sc[2 * kb][0], sc[2 * kb][1]); pk[1] = cvt_pk_bf16(sc[2 * kb][2], sc[2 * kb][3]); pk[2] = cvt_pk_bf16(sc[2 * kb + 1][0], sc[2 * kb + 1][1]); pk[3] = cvt_pk_bf16(sc[2 * kb + 1][2], sc[2 * kb + 1][3]);
            pB[kb] = __builtin_bit_cast(bf16x8, pk); }
#pragma unroll
        for (int dt = 0; dt < 4; ++dt) {
            f32x4 o = (f32x4){0.f, 0.f, 0.f, 0.f};
#pragma unroll
            for (int kb = 0; kb < 5; ++kb) { const LAS unsigned char* vp = Vl + (16 * dt + kl) * VP + (16 * (kt0 + 2 * kb) + 4 * seg) * 2;
                const u32x2 lo = *(const LAS u32x2*)(vp), hi = *(const LAS u32x2*)(vp + 32);
                const u32x4 av = (u32x4){lo.x, lo.y, hi.x, hi.y};
                o = __builtin_amdgcn_mfma_f32_16x16x32_bf16(__builtin_bit_cast(bf16x8, av), pB[kb], o, 0, 0, 0); }
            u32x2 wv; wv.x = cvt_pk_bf16(o[0] * inv, o[1] * inv); wv.y = cvt_pk_bf16(o[2] * inv, o[3] * inv);
            *(u32x2*)(OB + rowq * D + head * 64 + 16 * dt + 4 * seg) = wv;
        }
    }
    WG_BAR();
}
}

__device__ __forceinline__ float wave_sum(float v) {
#pragma unroll
    for (int o = 1; o < 64; o <<= 1) v += __shfl_xor(v, o);
    return v;
}
__device__ __forceinline__ void transpose_item(const float* W, int K, int N, bf16_t* WT, int row_off, int mode, const float* gain, int gmask, float scale, LAS float* scr, int item, int lane) {
    const int nblk = N / 32, kb = item / nblk, nb = item % nblk, k0 = 64 * kb, n0 = 32 * nb;
#pragma unroll 8
    for (int i = 0; i < 32; ++i) { const int kk = 2 * i + (lane >> 5); const float gsc = gain ? gain[(k0 + kk) & gmask] * scale : scale; scr[kk * 33 + (lane & 31)] = W[(size_t)(k0 + kk) * N + n0 + (lane & 31)] * gsc; }
    LDS_WAIT(); asm volatile("" ::: "memory");
    const int c = lane & 7;
#pragma unroll
    for (int j = 0; j < 4; ++j) { const int nl = (lane >> 3) + 8 * j, n = n0 + nl; const LAS float* s = scr + (8 * c) * 33 + nl;
        u32x4 o; o.x = cvt_pk_bf16(s[0 * 33], s[1 * 33]); o.y = cvt_pk_bf16(s[2 * 33], s[3 * 33]); o.z = cvt_pk_bf16(s[4 * 33], s[5 * 33]); o.w = cvt_pk_bf16(s[6 * 33], s[7 * 33]);
        int drow; if (mode == 0) drow = row_off + n; else { const int isv = n >= DFF ? 1 : 0, f = n - isv * DFF; drow = 256 * (f >> 7) + 128 * isv + (f & 127); }
        *(u32x4*)(WT + (size_t)drow * K + k0 + 8 * c) = o; }
    LDS_WAIT(); asm volatile("" ::: "memory");
}


#define XB_TMO      128
#define XB_XCNT(j)  (256  + 64 * (j))
#define XB_XSUB(j)  (1280 + 64 * (j))
#define XB_XGEN(j)  (2304 + 64 * (j))
#define XB_TOP      3328
#define XB_TOPGEN   3392
#define XCD_BAR_WORDS 3456
#define XB_SPIN_CAP (1u << 18)
__device__ __forceinline__ unsigned xb_ld(unsigned* p)              { return __hip_atomic_load(p, __ATOMIC_RELAXED, __HIP_MEMORY_SCOPE_AGENT); }
__device__ __forceinline__ unsigned xb_add(unsigned* p, unsigned v) { return __hip_atomic_fetch_add(p, v, __ATOMIC_RELAXED, __HIP_MEMORY_SCOPE_AGENT); }
__device__ __forceinline__ unsigned xb_xcc_id() { return (unsigned)__builtin_amdgcn_s_getreg((3 << 11) | 20) & 0xFu; }
#define XB_SPIN(cond, bar) do { unsigned _sp = 0; while (cond) { __builtin_amdgcn_s_sleep(1); \
    if ((++_sp & 255u) == 0u) { if (xb_ld(&(bar)[XB_TMO])) break; if (_sp > XB_SPIN_CAP) { atomicAdd(&(bar)[XB_TMO], 1u); break; } } } } while (0)
struct XcdBarrier { unsigned* bar; unsigned x; volatile LAS unsigned* st; };
__device__ __forceinline__ XcdBarrier xcd_barrier_post(unsigned* bar, volatile LAS unsigned* st) {
    XcdBarrier b; b.bar = bar; b.x = xb_xcc_id(); b.st = st;
    if (threadIdx.x == 0) (void)xb_add(&bar[XB_XCNT(b.x)], 1u);
    return b;
}
__device__ __forceinline__ void xcd_barrier_complete(unsigned* bar, unsigned x, unsigned& nloc, unsigned& nx) {
    const unsigned G = gridDim.x * gridDim.y * gridDim.z;
    unsigned sum, cnt, mine, sp = 0u;
    for (;;) {
        sum = 0u; cnt = 0u; mine = 0u;
#pragma unroll
        for (unsigned j = 0; j < 16; ++j) { const unsigned c = xb_ld(&bar[XB_XCNT(j)]); sum += c; cnt += (c > 0u) ? 1u : 0u; mine = (j == x) ? c : mine; }
        if (sum == G) break;
        __builtin_amdgcn_s_sleep(1);
        if ((++sp & 255u) == 0u) { if (xb_ld(&bar[XB_TMO])) break; if (sp > XB_SPIN_CAP) { atomicAdd(&bar[XB_TMO], 1u); break; } }
    }
    nloc = mine > 0u ? mine : 1u; nx = cnt > 0u ? cnt : 1u;
}
__device__ __forceinline__ void xcd_barrier(const XcdBarrier& b) {
    asm volatile("s_waitcnt vmcnt(0)" ::: "memory");
    __syncthreads();
    if (threadIdx.x == 0) {
        unsigned* bar = b.bar;
        __builtin_amdgcn_s_waitcnt(0);
        unsigned nloc = b.st[0], nx = b.st[1];
        if (nloc == 0u) { xcd_barrier_complete(bar, b.x, nloc, nx); b.st[0] = nloc; b.st[1] = nx; }
        const unsigned old = xb_add(&bar[XB_XSUB(b.x)], 1u);
        const unsigned gen = old / nloc;
        if (old + 1u == (gen + 1u) * nloc) {
            __builtin_amdgcn_fence(__ATOMIC_RELEASE, "agent");
            asm volatile("s_waitcnt vmcnt(0)" ::: "memory");
            const unsigned og = xb_add(&bar[XB_TOP], 1u);
            const unsigned tg = og / nx;
            if (og + 1u == (tg + 1u) * nx) xb_add(&bar[XB_TOPGEN], 1u);
            else XB_SPIN(xb_ld(&bar[XB_TOPGEN]) == tg, bar);
            __builtin_amdgcn_fence(__ATOMIC_ACQUIRE, "agent");
            xb_add(&bar[XB_XGEN(b.x)], 1u);
            asm volatile("s_waitcnt vmcnt(0)" ::: "memory");
        } else {
            XB_SPIN(xb_ld(&bar[XB_XGEN(b.x)]) == gen, bar);
            __builtin_amdgcn_fence(__ATOMIC_ACQUIRE, "agent");
            asm volatile("s_waitcnt vmcnt(0)" ::: "memory");
        }
    }
    __syncthreads();
}


__device__ __forceinline__ void ffn_fixup(const pg8::StaticOrder& S, bf16_t* Uo, const float* GH, const float* GS, const float* VS, const float* cw, const float* cb) {
    pg8::Unit u;
    for (int i = 0; S.next(i, u); ++i) {
        const int pm = u.pm; if ((pm & 15) == 0) continue;
#pragma unroll
        for (int it = 0; it < 2; ++it) {
            const int q = (int)threadIdx.x + 512 * it;
            if (q < DFF / 4) {
                const int f = 4 * q;
                const f32x4 g254 = *(const f32x4*)(GH + (size_t)((pm - 1) * 2 + 0) * DFF + f), g255 = *(const f32x4*)(GH + (size_t)((pm - 1) * 2 + 1) * DFF + f);
                const f32x4 g0 = *(const f32x4*)(GS + (size_t)(pm * 2 + 0) * DFF + f), g1 = *(const f32x4*)(GS + (size_t)(pm * 2 + 1) * DFF + f);
                const f32x4 v0 = *(const f32x4*)(VS + (size_t)(pm * 2 + 0) * DFF + f), v1 = *(const f32x4*)(VS + (size_t)(pm * 2 + 1) * DFF + f);
                const f32x4 w0 = *(const f32x4*)(cw + f), w1 = *(const f32x4*)(cw + DFF + f), w2 = *(const f32x4*)(cw + 2 * DFF + f), bb = *(const f32x4*)(cb + f);
                const f32x4 c0 = bb + w0 * g254 + w1 * g255 + w2 * g0, c1 = bb + w0 * g255 + w1 * g0 + w2 * g1;
                u32x2 o0, o1;
                o0[0] = cvt_pk_bf16(silu_f(c0[0]) * v0[0], silu_f(c0[1]) * v0[1]); o0[1] = cvt_pk_bf16(silu_f(c0[2]) * v0[2], silu_f(c0[3]) * v0[3]);
                o1[0] = cvt_pk_bf16(silu_f(c1[0]) * v1[0], silu_f(c1[1]) * v1[1]); o1[1] = cvt_pk_bf16(silu_f(c1[2]) * v1[2], silu_f(c1[3]) * v1[3]);
                *(u32x2*)(Uo + (size_t)(pm * 256 + 0) * DFF + f) = o0; *(u32x2*)(Uo + (size_t)(pm * 256 + 1) * DFF + f) = o1;
            }
        }
    }
    asm volatile("s_waitcnt vmcnt(0)" ::: "memory");
    __syncthreads();
}

struct Params {
    const float* in[18];
    float* out; unsigned char* ws;
};

constexpr int LDS_HALO_OFF = 131072;
constexpr int LDS_BYTES = 163840;
constexpr int LDS_XB_OFF = 163328;

__global__ void __launch_bounds__(512, 2) yoco_fwd(Params P) {
    extern __shared__ __attribute__((aligned(16))) unsigned char lds_raw[];
    LAS unsigned char* lds = (LAS unsigned char*)lds_raw;
    cg::grid_group grid = cg::this_grid();
    const int tid = threadIdx.x, lane = tid & 63, wave = __builtin_amdgcn_readfirstlane(tid >> 6);
    const int G = gridDim.x, bx = blockIdx.x;
#define x ((const float*)P.in[0])
#define hg_norm ((const float*)P.in[1])
#define hg_w_in ((const float*)P.in[2])
#define hg_lb ((const float*)P.in[3])
#define hg_out_norm ((const float*)P.in[4])
#define hg_w_out ((const float*)P.in[5])
#define kv_norm ((const float*)P.in[6])
#define w_kv ((const float*)P.in[7])
#define attn_norm ((const float*)P.in[8])
#define attn_w_q ((const float*)P.in[9])
#define attn_sinks ((const float*)P.in[10])
#define attn_w_o ((const float*)P.in[11])
#define ffn_norm ((const float*)P.in[12])
#define ffn_w_up ((const float*)P.in[13])
#define ffn_conv_w ((const float*)P.in[14])
#define ffn_conv_b ((const float*)P.in[15])
#define ffn_w_down ((const float*)P.in[16])
#define final_norm ((const float*)P.in[17])
#define RS ((float*)(P.ws + WS_RS))
#define WinT ((bf16_t*)(P.ws + WS_WIN))
#define WoutT ((bf16_t*)(P.ws + WS_WOUT))
#define WupT0 ((bf16_t*)(P.ws + WS_WUP0))
#define WdT0 ((bf16_t*)(P.ws + WS_WD0))
#define WqkvT ((bf16_t*)(P.ws + WS_WQKV))
#define WoT ((bf16_t*)(P.ws + WS_WO))
#define WupT1 ((bf16_t*)(P.ws + WS_WUP1))
#define WdT1 ((bf16_t*)(P.ws + WS_WD1))
#define HB ((bf16_t*)(P.ws + WS_HB))
#define H ((float*)(P.ws + WS_H))
#define QT ((bf16_t*)(P.ws + WS_QT))
#define FT ((bf16_t*)(P.ws + WS_FT))
#define IT ((bf16_t*)(P.ws + WS_IT))
#define GT ((bf16_t*)(P.ws + WS_GT))
#define AO ((bf16_t*)(P.ws + WS_AO))
#define OI ((bf16_t*)(P.ws + WS_OI))
#define DC ((float*)(P.ws + WS_DC))
#define U ((bf16_t*)(P.ws + WS_U))
#define QB ((bf16_t*)(P.ws + WS_QB))
#define KB ((bf16_t*)(P.ws + WS_KB))
#define VT ((bf16_t*)(P.ws + WS_VT))
#define OB ((bf16_t*)(P.ws + WS_OB))
#define FGH ((float*)(P.ws + WS_H))
#define FGS ((float*)(P.ws + WS_H + 4 * MiB))
#define FVS ((float*)(P.ws + WS_H + 8 * MiB))
    const int gw = bx * 8 + wave, NGW = G * 8;

    {
        LAS float* scr = (LAS float*)(lds + wave * 16384);
        for (int it = gw; it < 16 * 128; it += NGW) transpose_item(hg_w_in, D, 4 * D, WinT, 0, 0, hg_norm, 1023, 1.f, scr, it, lane);
        for (int m = gw; m < M; m += NGW) {
            const f32x4* xr = (const f32x4*)(x + (size_t)m * D) + lane; float s = 0.f;
            unsigned long long* o8 = (unsigned long long*)(HB + (size_t)m * D) + lane;
#pragma unroll
            for (int j = 0; j < 4; ++j) { const f32x4 v = xr[64 * j]; s += (v[0] * v[0] + v[1] * v[1]) + (v[2] * v[2] + v[3] * v[3]);
                o8[64 * j] = (unsigned long long)cvt_pk_bf16(v[0], v[1]) | ((unsigned long long)cvt_pk_bf16(v[2], v[3]) << 32); }
            s = wave_sum(s);
            if (lane == 0) RS[m] = s;
        }
        for (int i = bx * 512 + tid; i < 4 * M; i += G * 512) RS[M + i] = 0.f;
        if (bx == 0) for (int i = tid; i < XCD_BAR_WORDS; i += 512) ((unsigned*)(P.ws + WS_BAR))[i] = 0u;
        if (tid < 2) ((LAS unsigned*)(lds + LDS_XB_OFF))[tid] = 0u;
    }
    grid.sync();
    const XcdBarrier xbar = xcd_barrier_post((unsigned*)(P.ws + WS_BAR), (volatile LAS unsigned*)(lds + LDS_XB_OFF));

    {
        pg8::Gemm g{HB, WinT, M, 4 * D, D}; pg8::StaticOrder S; S.init(M / 256, 16, G, bx, 0);
        pg8::EpiHg E{P.ws, RS, hg_lb};
        pg8::gemm_phase<pg8::EpiHg, true>(lds, g, S, E);
    }
    xcd_barrier(xbar);

    for (int c = gw; c < 4096; c += NGW) hg::pass_a_chunk(lds + wave * hg::A_WAVE_LDS, (c & 63) * 128 + (c >> 6), QT, FT, IT, DC, OI, lane);
    xcd_barrier(xbar);
    unsigned* hgflag = (unsigned*)(P.ws + WS_BAR) + 3424;
    if (bx < 64) { for (int item = bx; item < 64; item += G) hg::pass_b_item(lds, item >> 3, item & 7, QT, FT, IT, GT, DC, OI, AO, hgflag, (unsigned)(G - 64)); }
    else {
        for (int c = (bx - 64) * 8 + wave; c < 4096; c += (G - 64) * 8) hg::pass_a_chunk(lds + wave * hg::A_WAVE_LDS, (c & 63) * 128 + 64 + (c >> 6), QT, FT, IT, DC, OI, lane);
        asm volatile("s_waitcnt vmcnt(0)" ::: "memory"); __syncthreads();
        if (tid == 0) { __builtin_amdgcn_fence(__ATOMIC_RELEASE, "agent"); asm volatile("s_waitcnt vmcnt(0)" ::: "memory"); __hip_atomic_fetch_add(hgflag, 1u, __ATOMIC_RELAXED, __HIP_MEMORY_SCOPE_AGENT); }
        LAS float* scr = (LAS float*)(lds + wave * 16384);
        constexpr int I_SQ = 16 * 32, I_UP = 16 * 176, I_DN = 44 * 32, I_KV = 16 * 8;
        constexpr int NIT = I_SQ + 2 * I_UP + 2 * I_DN + I_SQ + I_KV + I_SQ;
        for (int it = (bx - 64) * 8 + wave; it < NIT; it += (G - 64) * 8) {
            int r = it;
            if (r < I_SQ) { transpose_item(hg_w_out, D, D, WoutT, 0, 0, hg_out_norm, 127, 1.f, scr, r, lane); continue; } r -= I_SQ;
            if (r < I_UP) { transpose_item(ffn_w_up, D, 2 * DFF, WupT0, 0, 1, ffn_norm, 1023, 1.f, scr, r, lane); continue; } r -= I_UP;
            if (r < I_UP) { transpose_item(ffn_w_up + (size_t)D * 2 * DFF, D, 2 * DFF, WupT1, 0, 1, ffn_norm + D, 1023, 1.f, scr, r, lane); continue; } r -= I_UP;
            if (r < I_DN) { transpose_item(ffn_w_down, DFF, D, WdT0, 0, 0, nullptr, 0, 1.f, scr, r, lane); continue; } r -= I_DN;
            if (r < I_DN) { transpose_item(ffn_w_down + (size_t)DFF * D, DFF, D, WdT1, 0, 0, nullptr, 0, 1.f, scr, r, lane); continue; } r -= I_DN;
            if (r < I_SQ) { transpose_item(attn_w_q, D, D, WqkvT, 0, 0, attn_norm, 1023, 0.125f * LOG2E, scr, r, lane); continue; } r -= I_SQ;
            if (r < I_KV) { transpose_item(w_kv, D, 256, WqkvT, 1024, 0, kv_norm, 1023, 1.f, scr, r, lane); continue; } r -= I_KV;
            transpose_item(attn_w_o, D, D, WoT, 0, 0, nullptr, 0, 1.f, scr, r, lane);
        }
    }
    xcd_barrier(xbar);

    {
        pg8::Gemm g{AO, WoutT, M, D, D}; pg8::StaticOrder S; S.init(M / 256, 4, G, bx, 0);
        pg8::EpiRes E{HB, RS + M};
        pg8::gemm_phase<pg8::EpiRes, false, true>(lds, g, S, E);
    }
    xcd_barrier(xbar);

#define FFN_LAYER(layer) do { \
        { pg8::Gemm g{HB, layer == 0 ? WupT0 : WupT1, M, 2 * DFF, D}; pg8::StaticOrder S; S.init(M / 256, 22, G, bx, 0); \
          pg8::EpiFfn E{U, RS + (layer == 0 ? 1 : 3) * M, ffn_conv_w + (size_t)layer * 3 * DFF, ffn_conv_b + (size_t)layer * DFF, (LAS float*)(lds + LDS_HALO_OFF), FGH, FGS, FVS}; \
          pg8::gemm_phase<pg8::EpiFfn, false, true>(lds, g, S, E); } \
        xcd_barrier(xbar); \
        { pg8::Gemm g{U, layer == 0 ? WdT0 : WdT1, M, D, DFF}; pg8::StaticOrder S; S.init(M / 256, 4, G, bx, 0); \
          ffn_fixup(S, U, FGH, FGS, FVS, ffn_conv_w + (size_t)layer * 3 * DFF, ffn_conv_b + (size_t)layer * DFF); \
          pg8::EpiRes E{HB, RS + (layer == 0 ? 2 : 4) * M}; \
          pg8::gemm_phase<pg8::EpiRes, false, true>(lds, g, S, E); } \
        xcd_barrier(xbar); } while (0)

    FFN_LAYER(0);
    {
        pg8::Gemm g{HB, WqkvT, M, 1280, D}; pg8::StaticOrder S; S.init(M / 256, 5, G, bx, 0);
        pg8::EpiQkv E{QB, KB, VT, RS + 2 * M};
        pg8::gemm_phase<pg8::EpiQkv, false, true>(lds, g, S, E);
    }
    xcd_barrier(xbar);
    for (int item = bx; item < 512; item += G) { const int nb = item & 31, kvh = (item >> 5) & 1, b = item >> 6; att::attn_item(lds, b, kvh, nb, QB, KB, VT, OB, attn_sinks); }
    xcd_barrier(xbar);
    {
        pg8::Gemm g{OB, WoT, M, D, D}; pg8::StaticOrder S; S.init(M / 256, 4, G, bx, 0);
        pg8::EpiRes E{HB, RS + 3 * M};
        pg8::gemm_phase<pg8::EpiRes, false, true>(lds, g, S, E);
    }
    xcd_barrier(xbar);
    FFN_LAYER(1);

    for (int m = gw; m < M; m += NGW) {
        const float rs = rsqrtf(RS[4 * M + m] * (1.f / D) + EPS);
        const u32x2* hrow = (const u32x2*)(HB + (size_t)m * D) + lane; f32x4* orow = (f32x4*)(P.out + (size_t)m * D) + lane; const f32x4* gn = (const f32x4*)final_norm + lane;
#pragma unroll
        for (int j = 0; j < 4; ++j) { const u32x2 hv = hrow[64 * j]; const f32x4 v = (f32x4){bf_lo(hv[0]), bf_hi(hv[0]), bf_lo(hv[1]), bf_hi(hv[1])}; orow[64 * j] = v * rs * gn[64 * j]; }
    }
}

extern "C" void kernel_launch(void* const* d_in, const int* in_sizes, int n_in, void* d_out, int out_size, void* d_ws, size_t ws_size, hipStream_t stream) {
    static int grid_blocks = 0;
    if (grid_blocks == 0) {
        if (n_in != 18 || in_sizes[0] != M * D || out_size != M * D || ws_size < WS_END) { fprintf(stderr, "kernel_launch: unexpected shapes (n_in %d, in0 %d, out %d, ws %zu)\n", n_in, n_in > 0 ? in_sizes[0] : -1, out_size, ws_size); grid_blocks = -1; return; }
        int dev = 0, cus = 0, per_cu = 0;
        hipGetDevice(&dev);
        hipDeviceGetAttribute(&cus, hipDeviceAttributeMultiprocessorCount, dev);
        hipFuncSetAttribute((const void*)yoco_fwd, hipFuncAttributeMaxDynamicSharedMemorySize, LDS_BYTES);
        hipOccupancyMaxActiveBlocksPerMultiprocessor(&per_cu, (const void*)yoco_fwd, 512, LDS_BYTES);
        if (per_cu < 1) { fprintf(stderr, "kernel_launch: occupancy query says %d blocks per CU\n", per_cu); grid_blocks = -1; return; }
        grid_blocks = cus;
    }
    if (grid_blocks < 0) return;
    Params p{};
    for (int i = 0; i < 18; ++i) p.in[i] = (const float*)d_in[i];
    p.out = (float*)d_out; p.ws = (unsigned char*)d_ws;
    void* args[] = {&p};
    hipError_t e = hipLaunchCooperativeKernel((const void*)yoco_fwd, dim3(grid_blocks), dim3(512), args, LDS_BYTES, stream);
    if (e != hipSuccess) fprintf(stderr, "cooperative launch failed: %s (grid %d)\n", hipGetErrorString(e), grid_blocks);
}
```

```cpp
#include <hip/hip_runtime.h>
#include <hip/hip_cooperative_groups.h>
#include <cstdio>
#include <cstdint>
namespace cg = cooperative_groups;

#define LAS __attribute__((address_space(3)))
typedef unsigned short bf16_t;
typedef short bf16x8 __attribute__((ext_vector_type(8)));
typedef short s16x4 __attribute__((ext_vector_type(4)));
typedef float f32x4 __attribute__((ext_vector_type(4)));
typedef unsigned u32x4 __attribute__((ext_vector_type(4)));
typedef unsigned u32x2 __attribute__((ext_vector_type(2)));

constexpr int D = 1024, BATCH = 8, SEQ = 4096, M = BATCH * SEQ, DFF = 2816;
constexpr float EPS = 1e-6f;
constexpr float LOG2E = 1.4426950408889634f;

constexpr size_t MiB = 1u << 20;
constexpr size_t WS_RS = 0;
constexpr size_t WS_BAR = 768 * 1024;
constexpr size_t WS_WIN = 1 * MiB, WS_WOUT = 9 * MiB, WS_WUP0 = 11 * MiB, WS_WD0 = 22 * MiB, WS_WQKV = 28 * MiB, WS_WO = 31 * MiB, WS_WUP1 = 33 * MiB, WS_WD1 = 44 * MiB;
constexpr size_t WS_HB = 51 * MiB;
constexpr size_t WS_H = 116 * MiB;
constexpr size_t WS_T = 244 * MiB;
constexpr size_t WS_QT = WS_T, WS_FT = WS_T + 64 * MiB, WS_IT = WS_T + 128 * MiB, WS_AO = WS_T + 192 * MiB, WS_GT = WS_H, WS_OI = WS_H + 64 * MiB, WS_DC = WS_T + 256 * MiB;
constexpr size_t WS_U = WS_T;
constexpr size_t WS_QB = WS_T, WS_KB = WS_T + 64 * MiB, WS_VT = WS_T + 72 * MiB, WS_OB = WS_T + 80 * MiB;
constexpr size_t WS_END = 512 * MiB;

typedef float f32x2_t __attribute__((ext_vector_type(2))); typedef __bf16 bf16x2_t __attribute__((ext_vector_type(2)));
__device__ __forceinline__ unsigned cvt_pk_bf16(float lo, float hi) { const f32x2_t v = {lo, hi}; const bf16x2_t r = __builtin_convertvector(v, bf16x2_t); return __builtin_bit_cast(unsigned, r); }
__device__ __forceinline__ bf16_t f2bf(float f) { return (bf16_t)(cvt_pk_bf16(f, 0.f) & 0xffffu); }
__device__ __forceinline__ float bf_lo(unsigned u) { return __uint_as_float(u << 16); }
__device__ __forceinline__ float bf_hi(unsigned u) { return __uint_as_float(u & 0xffff0000u); }
__device__ __forceinline__ float ex2(float x) { return __builtin_amdgcn_exp2f(x); }
__device__ __forceinline__ float rcpf_(float x) { return __builtin_amdgcn_rcpf(x); }
__device__ __forceinline__ float sigmoid_f(float v) { return rcpf_(1.f + ex2(-LOG2E * v)); }
__device__ __forceinline__ float silu_f(float v) { return v * sigmoid_f(v); }
template <int CTRL> __device__ __forceinline__ float row_ror_t(float v) { return __builtin_bit_cast(float, __builtin_amdgcn_update_dpp(0, __builtin_bit_cast(int, v), CTRL, 0xf, 0xf, false)); }
#define row_ror_f(v, ctrl) row_ror_t<ctrl>(v)
#define LDS_WAIT() asm volatile("s_waitcnt lgkmcnt(0)" ::: "memory")
#define WG_BAR() do { asm volatile("s_waitcnt lgkmcnt(0)" ::: "memory"); __builtin_amdgcn_s_barrier(); asm volatile("" ::: "memory"); } while (0)

namespace pg8 {
constexpr int BM = 256, BK = 64, HALF = 128, HTB = HALF * BK * 2, STAGE_BYTES = 8 * HTB, NXCD = 8, WGM = 8;
__host__ __device__ __forceinline__ int lds_byte(int r, int c) { const int st = (r >> 4) * 2 + (c >> 5), rr = r & 15, cc = c & 31, ob = rr * 64 + cc * 2; return st * 1024 + (ob ^ (((ob >> 9) & 1) << 5)); }
__host__ __device__ __forceinline__ int perm32(int rho) { const int n = rho >> 4, i = rho & 15; return 8 * (i >> 2) + 4 * n + (i & 3); }
__host__ __device__ __forceinline__ void stage_rc(int b, int& R, int& C) { const int st = b / 1024, sb = b % 1024, swz = sb ^ (((sb >> 9) & 1) << 5); R = (st >> 1) * 16 + swz / 64; C = (st & 1) * 32 + (swz % 64) / 2; }

struct Unit { int pm, pn, arow; };
struct Gemm { const bf16_t* A; const bf16_t* Bt; int M, N, K; };

struct StaticOrder {
    int nM, nN, nwg, G, c, ovl;
    __device__ void init(int nM_, int nN_, int G_, int c_, int ovl_) { nM = nM_; nN = nN_; nwg = nM * nN; G = G_; c = c_; ovl = ovl_; }
    __device__ bool next(int i, Unit& u) const {
        const long L = (long)i * G + c; if (L >= nwg) return false;
        int wgid = (int)L; { const int q = nwg / NXCD, r = nwg % NXCD, xcd = wgid % NXCD, off = wgid / NXCD; wgid = (xcd < r ? xcd * (q + 1) : r * (q + 1) + (xcd - r) * q) + off; }
        const int nig = WGM * nN, gid = wgid / nig, fm = gid * WGM, gsz = (nM - fm) < WGM ? (nM - fm) : WGM;
        u.pm = fm + ((wgid % nig) % gsz); u.pn = (wgid % nig) / gsz;
        u.arow = ovl ? (u.pm / 17) * SEQ + 254 * (u.pm % 17) - 2 : u.pm * BM;
        return true;
    }
};

template <class Epi, bool SWAP, bool PERM = false>
__device__ __forceinline__ void gemm_phase(LAS unsigned char* lds, const Gemm g, const StaticOrder& S, const Epi& E) {
    int tid = threadIdx.x; asm volatile("" : "+v"(tid));
    const int wid = __builtin_amdgcn_readfirstlane(tid >> 6), lane = tid & 63, wr = wid >> 2, wc = wid & 3, fr = lane & 15, fq = lane >> 4;
    const int K = g.K, nt = K / BK;
    unsigned voffA[2], voffB[2];
#pragma unroll
    for (int i = 0; i < 2; ++i) { int R, C; stage_rc(tid * 16 + i * 8192, R, C); voffA[i] = (unsigned)(R * K + C) * 2u; const int Rb = PERM ? ((R & ~31) + perm32(R & 31)) : R; voffB[i] = (unsigned)(Rb * K + C) * 2u; }
    const size_t kstep = (size_t)(BK * 2);
    const size_t hstep = (size_t)HALF * K * 2;
    const size_t tstep = 2 * hstep;
    const long rowb = (long)K * 2;
    const unsigned ldsw = (unsigned)wid * 1024u;
    const int aoff = lds_byte(wr * 64 + fr, fq * 8), boff = lds_byte(wc * 32 + fr, fq * 8);
#define PG8_SA(b, h) (((b) * 2 + (h)) * HTB)
#define PG8_SB(b, h) ((4 + (b) * 2 + (h)) * HTB)
#define PG8_STAGE(bufoff, gbase, voff) do { _Pragma("unroll") for (int _i = 0; _i < 2; ++_i) \
        __builtin_amdgcn_global_load_lds((const unsigned*)((const char*)(gbase) + (voff)[_i]), (LAS unsigned*)(lds + (bufoff) + ldsw + _i * 8192), 16, 0, 0); } while (0)
#define PG8_LDA(dst, b, h) do { _Pragma("unroll") for (int m = 0; m < 4; ++m) _Pragma("unroll") for (int k = 0; k < 2; ++k) dst[m][k] = *(const LAS bf16x8*)(lds + PG8_SA(b, h) + aoff + m * 2048 + k * 1024); } while (0)
#define PG8_LDB(dst, b, h) do { _Pragma("unroll") for (int n = 0; n < 2; ++n) _Pragma("unroll") for (int k = 0; k < 2; ++k) dst[n][k] = *(const LAS bf16x8*)(lds + PG8_SB(b, h) + boff + n * 2048 + k * 1024); } while (0)
#define PG8_MMA(ai, bj, At, Bt) do { __builtin_amdgcn_s_setprio(1); _Pragma("unroll") for (int m = 0; m < 4; ++m) _Pragma("unroll") for (int n = 0; n < 2; ++n) _Pragma("unroll") for (int k = 0; k < 2; ++k) { \
        if constexpr (SWAP) acc[ai][bj][m][n] = __builtin_amdgcn_mfma_f32_16x16x32_bf16(At[m][k], Bt[n][k], acc[ai][bj][m][n], 0, 0, 0); \
        else acc[ai][bj][m][n] = __builtin_amdgcn_mfma_f32_16x16x32_bf16(Bt[n][k], At[m][k], acc[ai][bj][m][n], 0, 0, 0); } __builtin_amdgcn_s_setprio(0); } while (0)
#define PG8_WAIT_V(n) asm volatile("s_waitcnt vmcnt(" #n ")" ::: "memory")
#define PG8_WAIT_L(n) asm volatile("s_waitcnt lgkmcnt(" #n ")" ::: "memory")
#define PG8_BAR __builtin_amdgcn_s_barrier()
#define PG8_SCHED __builtin_amdgcn_sched_barrier(0)
    Unit cur, nxt; int ui = 0;
    if (!S.next(0, cur)) return;
    f32x4 acc[2][2][4][2];
#pragma unroll
    for (int a = 0; a < 2; ++a)
#pragma unroll
        for (int b = 0; b < 2; ++b)
#pragma unroll
            for (int m = 0; m < 4; ++m)
#pragma unroll
                for (int n = 0; n < 2; ++n) acc[a][b][m][n] = (f32x4){0.f, 0.f, 0.f, 0.f};
    bf16x8 At[4][2], B0[2][2], B1[2][2];
    const char* cA = (const char*)g.A + (long)cur.arow * rowb; const char* cB = (const char*)g.Bt + (size_t)cur.pn * tstep;
    PG8_STAGE(PG8_SB(0, 0), cB, voffB); PG8_STAGE(PG8_SB(0, 1), cB + hstep, voffB); PG8_STAGE(PG8_SA(0, 0), cA, voffA); PG8_STAGE(PG8_SA(0, 1), cA + hstep, voffA);
    if (wr == 1) PG8_BAR;
    PG8_WAIT_V(2); PG8_BAR;
    PG8_STAGE(PG8_SB(1, 0), cB + kstep, voffB); PG8_STAGE(PG8_SA(1, 0), cA + kstep, voffA); PG8_STAGE(PG8_SB(1, 1), cB + hstep + kstep, voffB);
    PG8_WAIT_V(6); PG8_BAR;
    for (;;) {
        const bool has_next = S.next(ui + 1, nxt);
        const char* nA = has_next ? (const char*)g.A + (long)nxt.arow * rowb : cA; const char* nB = has_next ? (const char*)g.Bt + (size_t)nxt.pn * tstep : cB;
        for (int t = 0; t < nt; t += 2) {
            const bool last = (t == nt - 2);
            const char* a1 = cA + (size_t)(t + 1) * kstep;
            const char* a2 = last ? nA : cA + (size_t)(t + 2) * kstep; const char* b2 = last ? nB : cB + (size_t)(t + 2) * kstep;
            const char* a3 = a2 + kstep; const char* b3 = b2 + kstep;
            PG8_LDB(B0, 0, 0); PG8_LDB(B1, 0, 1); PG8_SCHED; PG8_LDA(At, 0, 0); PG8_STAGE(PG8_SA(1, 1), a1 + hstep, voffA);
            PG8_WAIT_V(8); PG8_WAIT_L(0); PG8_BAR; PG8_MMA(0, 0, At, B0); PG8_MMA(0, 1, At, B1); PG8_BAR; PG8_SCHED;
            PG8_LDA(At, 0, 1); PG8_STAGE(PG8_SB(0, 0), b2, voffB); PG8_STAGE(PG8_SB(0, 1), b2 + hstep, voffB); PG8_STAGE(PG8_SA(0, 0), a2, voffA);
            PG8_WAIT_V(8); PG8_WAIT_L(0); PG8_BAR; PG8_MMA(1, 0, At, B0); PG8_MMA(1, 1, At, B1); PG8_BAR; PG8_SCHED;
            PG8_LDB(B0, 1, 0); PG8_LDB(B1, 1, 1); PG8_SCHED; PG8_LDA(At, 1, 0); PG8_STAGE(PG8_SA(0, 1), a2 + hstep, voffA);
            PG8_WAIT_V(8); PG8_WAIT_L(0); PG8_BAR; PG8_MMA(0, 0, At, B0); PG8_MMA(0, 1, At, B1); PG8_BAR; PG8_SCHED;
            PG8_LDA(At, 1, 1); PG8_STAGE(PG8_SB(1, 0), b3, voffB); PG8_STAGE(PG8_SB(1, 1), b3 + hstep, voffB); PG8_STAGE(PG8_SA(1, 0), a3, voffA);
            PG8_WAIT_V(8); PG8_WAIT_L(0); PG8_BAR; PG8_MMA(1, 0, At, B0); PG8_MMA(1, 1, At, B1); PG8_BAR; PG8_SCHED;
        }
        if (wr == 0) PG8_BAR;
        E(acc, cur, wr, wc, fr, fq);
        if (!has_next) break;
#pragma unroll
        for (int a = 0; a < 2; ++a)
#pragma unroll
            for (int b = 0; b < 2; ++b)
#pragma unroll
                for (int m = 0; m < 4; ++m)
#pragma unroll
                    for (int n = 0; n < 2; ++n) acc[a][b][m][n] = (f32x4){0.f, 0.f, 0.f, 0.f};
        cur = nxt; cA = nA; cB = nB; ++ui;
        if (wr == 1) PG8_BAR;
    }
    PG8_WAIT_V(0);
    PG8_BAR;
#undef PG8_SA
#undef PG8_SB
#undef PG8_STAGE
#undef PG8_LDA
#undef PG8_LDB
#undef PG8_MMA
#undef PG8_WAIT_V
#undef PG8_WAIT_L
#undef PG8_BAR
#undef PG8_SCHED
}


struct EpiRes {
    bf16_t* hb; float* rowss;
    __device__ __forceinline__ void operator()(const f32x4 (&acc)[2][2][4][2], const Unit& u, int wr, int wc, int fr, int fq) const {
#pragma unroll
        for (int ai = 0; ai < 2; ++ai)
#pragma unroll
            for (int m = 0; m < 4; ++m) {
                const int row = u.pm * BM + ai * HALF + wr * 64 + m * 16 + fr; float ss = 0.f;
#pragma unroll
                for (int bj = 0; bj < 2; ++bj) {
                    const size_t off = (size_t)row * D + u.pn * BM + bj * HALF + wc * 32 + 8 * fq;
                    const u32x4 hv = *(const u32x4*)(hb + off);
                    f32x4 v0 = acc[ai][bj][m][0], v1 = acc[ai][bj][m][1];
                    v0[0] += bf_lo(hv[0]); v0[1] += bf_hi(hv[0]); v0[2] += bf_lo(hv[1]); v0[3] += bf_hi(hv[1]);
                    v1[0] += bf_lo(hv[2]); v1[1] += bf_hi(hv[2]); v1[2] += bf_lo(hv[3]); v1[3] += bf_hi(hv[3]);
                    *(u32x4*)(hb + off) = (u32x4){cvt_pk_bf16(v0[0], v0[1]), cvt_pk_bf16(v0[2], v0[3]), cvt_pk_bf16(v1[0], v1[1]), cvt_pk_bf16(v1[2], v1[3])};
                    ss += ((v0[0] * v0[0] + v0[1] * v0[1]) + (v0[2] * v0[2] + v0[3] * v0[3])) + ((v1[0] * v1[0] + v1[1] * v1[1]) + (v1[2] * v1[2] + v1[3] * v1[3]));
                }
                ss += __shfl_xor(ss, 16); ss += __shfl_xor(ss, 32);
                if (fq == 0) unsafeAtomicAdd(rowss + row, ss);
                asm volatile("" ::: "memory");
            }
    }
};

struct EpiQkv {
    bf16_t* QB; bf16_t* KB; bf16_t* VT; const float* rowss;
    __device__ __forceinline__ void operator()(const f32x4 (&acc)[2][2][4][2], const Unit& u, int wr, int wc, int fr, int fq) const {
#pragma unroll
        for (int ai = 0; ai < 2; ++ai)
#pragma unroll
            for (int m = 0; m < 4; ++m) {
                const int row = u.pm * BM + ai * HALF + wr * 64 + m * 16 + fr;
                const float rs = rsqrtf(rowss[row] * (1.f / D) + EPS);
#pragma unroll
                for (int bj = 0; bj < 2; ++bj) {
                    const f32x4 v0 = acc[ai][bj][m][0] * rs, v1 = acc[ai][bj][m][1] * rs; const int cl = wc * 32 + 8 * fq;
                    const u32x4 w = (u32x4){cvt_pk_bf16(v0[0], v0[1]), cvt_pk_bf16(v0[2], v0[3]), cvt_pk_bf16(v1[0], v1[1]), cvt_pk_bf16(v1[2], v1[3])};
                    if (u.pn < 4) *(u32x4*)(QB + (size_t)row * D + u.pn * BM + bj * HALF + cl) = w;
                    else if (bj == 0) *(u32x4*)(KB + (size_t)row * 128 + cl) = w;
                    else { const int b = row >> 12, s = row & (SEQ - 1);
#pragma unroll
                        for (int e = 0; e < 8; ++e) { const int c = cl + e; const float ve = e < 4 ? v0[e & 3] : v1[e & 3];
                            VT[((size_t)(((b * 2 + (c >> 6)) * 32 + (s >> 7)) * 64 + (c & 63))) * 128 + (s & 127)] = f2bf(ve); } }
                }
            }
    }
};

struct EpiHg {
    unsigned char* wsb; const float* rowss; const float* lbl;
    __device__ __forceinline__ void operator()(const f32x4 (&acc)[2][2][4][2], const Unit& u, int wr, int wc, int fr, int fq) const {
        const int sec = u.pn >> 2, b = u.pm >> 4, sb = (u.pm & 15) * BM;
        bf16_t* Tp = (bf16_t*)(wsb + (sec == 3 ? WS_GT : WS_QT + (size_t)sec * (64 * MiB)));
        f32x4 ssall[2][4];
#pragma unroll
        for (int ai = 0; ai < 2; ++ai)
#pragma unroll
            for (int m = 0; m < 4; ++m) ssall[ai][m] = *(const f32x4*)(rowss + u.pm * BM + ai * HALF + wr * 64 + m * 16 + 4 * fq);
        float l0[2][2], l1[2][2];
#pragma unroll
        for (int bj = 0; bj < 2; ++bj)
#pragma unroll
            for (int n = 0; n < 2; ++n) { const int c1 = (u.pn & 3) * BM + bj * HALF + wc * 32 + n * 16 + fr; l0[bj][n] = lbl[c1]; l1[bj][n] = lbl[D + c1]; }
        asm volatile("" ::: "memory");
        float lbv[2][2];
#pragma unroll
        for (int bj = 0; bj < 2; ++bj)
#pragma unroll
            for (int n = 0; n < 2; ++n) lbv[bj][n] = rcpf_(1.f + ex2(LOG2E * (l1[bj][n] - l0[bj][n])));
#pragma unroll
        for (int ai = 0; ai < 2; ++ai)
#pragma unroll
            for (int m = 0; m < 4; ++m) {
                const int rl = ai * HALF + wr * 64 + m * 16 + 4 * fq;
                const f32x4 ssv = ssall[ai][m];
                f32x4 rs; rs[0] = rsqrtf(ssv[0] * (1.f / D) + EPS); rs[1] = rsqrtf(ssv[1] * (1.f / D) + EPS); rs[2] = rsqrtf(ssv[2] * (1.f / D) + EPS); rs[3] = rsqrtf(ssv[3] * (1.f / D) + EPS);
#pragma unroll
                for (int bj = 0; bj < 2; ++bj)
#pragma unroll
                    for (int n = 0; n < 2; ++n) {
                        f32x4 v = acc[ai][bj][m][n] * rs;
                        if (sec == 0) { v[0] = silu_f(v[0]) * 0.08838834764831845f; v[1] = silu_f(v[1]) * 0.08838834764831845f; v[2] = silu_f(v[2]) * 0.08838834764831845f; v[3] = silu_f(v[3]) * 0.08838834764831845f; }
                        else if (sec == 1) { const float lb = lbv[bj][n], om = 1.f - lb;
#pragma unroll
                            for (int e = 0; e < 4; ++e) v[e] = om * sigmoid_f(-v[e]); (void)lb; }
                        else if (sec == 3) { v[0] = silu_f(v[0]); v[1] = silu_f(v[1]); v[2] = silu_f(v[2]); v[3] = silu_f(v[3]); }
                        const int head = 2 * (u.pn & 3) + bj, c = wc * 32 + n * 16 + fr;
                        u32x2 w; w.x = cvt_pk_bf16(v[0], v[1]); w.y = cvt_pk_bf16(v[2], v[3]);
                        { const int sa = sb + rl; bf16_t* cb = Tp + ((size_t)((b * 8 + head) * 128 + (sa >> 5))) * 4096;
                          if (sec == 3) *(u32x2*)(cb + (2 * wc + n) * 512 + (fq * 16 + fr) * 8 + (m & 1) * 4) = w;
                          else *(u32x2*)(cb + c * 32 + (sa & 31)) = w; }
                    }
            }
    }
};

struct EpiFfn {
    bf16_t* U; const float* rowss; const float* cw; const float* cb; LAS float* halo; float* GH; float* GS; float* VS;
    __device__ __forceinline__ void operator()(f32x4 (&acc)[2][2][4][2], const Unit& u, int wr, int wc, int fr, int fq) const {
        const int t0 = (u.pm & 15) * BM, lane = fr + 16 * fq; const bool first = t0 == 0;
#pragma unroll
        for (int ai = 0; ai < 2; ++ai)
#pragma unroll
            for (int m = 0; m < 4; ++m) {
                const float rs = rsqrtf(rowss[u.pm * BM + ai * HALF + wr * 64 + m * 16 + fr] * (1.f / D) + EPS);
#pragma unroll
                for (int bj = 0; bj < 2; ++bj)
#pragma unroll
                    for (int n = 0; n < 2; ++n) acc[ai][bj][m][n] = acc[ai][bj][m][n] * rs;
            }
        if (fr >= 14) {
#pragma unroll
            for (int ai = 0; ai < 2; ++ai)
#pragma unroll
                for (int n = 0; n < 2; ++n) *(LAS f32x4*)(halo + ((2 * ai + wr) * 2 + (15 - fr)) * 128 + wc * 32 + 8 * fq + 4 * n) = acc[ai][0][3][n];
        }
        WG_BAR();
        u32x2 keep[2][4];
#pragma unroll
        for (int n = 0; n < 2; ++n) {
            const int f0 = u.pn * 128 + wc * 32 + 8 * fq + 4 * n;
            const f32x4 w0 = *(const f32x4*)(cw + f0), w1 = *(const f32x4*)(cw + DFF + f0), w2 = *(const f32x4*)(cw + 2 * DFF + f0), bb = *(const f32x4*)(cb + f0);
#pragma unroll
            for (int ai = 0; ai < 2; ++ai) {
                const int blk = 2 * ai + wr;
                f32x4 h1 = (f32x4){0.f, 0.f, 0.f, 0.f}, h2 = h1;
                if (blk > 0) { h1 = *(const LAS f32x4*)(halo + ((blk - 1) * 2 + 0) * 128 + wc * 32 + 8 * fq + 4 * n); h2 = *(const LAS f32x4*)(halo + ((blk - 1) * 2 + 1) * 128 + wc * 32 + 8 * fq + 4 * n); }
                f32x4 r1p = h1, r2p = h2;
#pragma unroll
                for (int m = 0; m < 4; ++m) {
                    const f32x4 g = acc[ai][0][m][n];
                    f32x4 r1, r2;
#pragma unroll
                    for (int e = 0; e < 4; ++e) { r1[e] = row_ror_f(g[e], 0x121); r2[e] = row_ror_f(g[e], 0x122); }
                    f32x4 p1, p2;
                    if (m == 0) {
#pragma unroll
                        for (int e = 0; e < 4; ++e) { p1[e] = fr >= 1 ? r1[e] : h1[e]; p2[e] = fr >= 2 ? r2[e] : (fr == 1 ? h1[e] : h2[e]); }
                    } else {
#pragma unroll
                        for (int e = 0; e < 4; ++e) { p1[e] = fr >= 1 ? r1[e] : r1p[e]; p2[e] = fr >= 2 ? r2[e] : r2p[e]; }
                    }
                    r1p = r1; r2p = r2;
                    const int rl = ai * HALF + wr * 64 + m * 16 + fr, t = t0 + rl;
                    if (t < 1) p1 = (f32x4){0.f, 0.f, 0.f, 0.f};
                    if (t < 2) p2 = (f32x4){0.f, 0.f, 0.f, 0.f};
                    const f32x4 cv = bb + w0 * p2 + w1 * p1 + w2 * g;
                    const f32x4 vv = acc[ai][1][m][n];
                    f32x4 o; o[0] = silu_f(cv[0]) * vv[0]; o[1] = silu_f(cv[1]) * vv[1]; o[2] = silu_f(cv[2]) * vv[2]; o[3] = silu_f(cv[3]) * vv[3];
                    if (rl >= 2 || first) { u32x2 w; w[0] = cvt_pk_bf16(o[0], o[1]); w[1] = cvt_pk_bf16(o[2], o[3]);
                        if (n == 0) keep[ai][m] = w; else *(u32x4*)(U + (size_t)(u.pm * BM + rl) * DFF + f0 - 4) = (u32x4){keep[ai][m][0], keep[ai][m][1], w[0], w[1]}; }
                    else { *(f32x4*)(GS + (size_t)(u.pm * 2 + rl) * DFF + f0) = g; *(f32x4*)(VS + (size_t)(u.pm * 2 + rl) * DFF + f0) = vv; }
                    if (rl >= 254) *(f32x4*)(GH + (size_t)(u.pm * 2 + rl - 254) * DFF + f0) = g;
                }
            }
        }
    }
};
}

namespace hg {
constexpr int A_WAVE_LDS = 5120;
constexpr int RING = 19456, OTP = 272;
static_assert(8 * A_WAVE_LDS <= 131072, "hgrn lds");

__device__ __forceinline__ void pass_a_chunk(LAS unsigned char* ldsw, int cidx, bf16_t* QT, bf16_t* FT, const bf16_t* IT, float* DC, bf16_t* OI, int lane) {
    const int kl = lane & 15, seg = lane >> 4;
    bf16_t* qc = QT + (size_t)cidx * 4096; bf16_t* fc = FT + (size_t)cidx * 4096; (void)IT;
    float* dc = DC + (size_t)cidx * 256; bf16_t* oi = OI + (size_t)cidx * 1024;
    LAS unsigned char* Qs = ldsw; LAS unsigned char* Ks = ldsw + 2560;
    f32x4 sc[2][2];
#pragma unroll
    for (int a = 0; a < 2; ++a)
#pragma unroll
        for (int b = 0; b < 2; ++b) sc[a][b] = (f32x4){0.f, 0.f, 0.f, 0.f};
    u32x4 qall[8], fall[8];
#pragma unroll
    for (int kg = 0; kg < 8; ++kg) { qall[kg] = *(const u32x4*)(qc + (16 * kg + kl) * 32 + 8 * seg); fall[kg] = *(const u32x4*)(fc + (16 * kg + kl) * 32 + 8 * seg); }
#pragma unroll
    for (int ks = 0; ks < 4; ++ks) {
#pragma unroll
        for (int kgl = 0; kgl < 2; ++kgl) {
            const int kg = 2 * ks + kgl;
            const u32x4 qv4 = qall[kg], fv4 = fall[kg];
            float kk[8], qv[8];
#pragma unroll
            for (int i = 0; i < 4; ++i) { kk[2 * i] = bf_lo(fv4[i]); kk[2 * i + 1] = bf_hi(fv4[i]); qv[2 * i] = bf_lo(qv4[i]); qv[2 * i + 1] = bf_hi(qv4[i]); }
            float pr[8]; float p = 1.f;
#pragma unroll
            for (int j = 0; j < 8; ++j) { p *= (1.f - kk[j]); pr[j] = p; }
            const float t0 = __shfl(p, kl), t1 = __shfl(p, kl + 16), t2 = __shfl(p, kl + 32), t3 = __shfl(p, kl + 48);
            const float offs = (seg > 0 ? t0 : 1.f) * (seg > 1 ? t1 : 1.f) * (seg > 2 ? t2 : 1.f), dC = (t0 * t1) * (t2 * t3);
            float kh[8];
#pragma unroll
            for (int j = 0; j < 8; ++j) { const float e = pr[j] * offs, kt = kk[j] * rcpf_(e); kh[j] = kt * dC;
                *(LAS bf16_t*)(Qs + (8 * seg + j) * 80 + (16 * kgl + kl) * 2) = f2bf(qv[j] * e);
                *(LAS bf16_t*)(Ks + (8 * seg + j) * 80 + (16 * kgl + kl) * 2) = f2bf(kt); }
            u32x4 khp; khp[0] = cvt_pk_bf16(kh[0], kh[1]); khp[1] = cvt_pk_bf16(kh[2], kh[3]); khp[2] = cvt_pk_bf16(kh[4], kh[5]); khp[3] = cvt_pk_bf16(kh[6], kh[7]);
            *(u32x4*)(fc + kg * 512 + lane * 8) = khp;
            if (seg == 0) dc[16 * kg + kl] = dC;
        }
        bf16x8 Af[2], Bf[2];
#pragma unroll
        for (int st = 0; st < 2; ++st) Af[st] = *(const LAS bf16x8*)(Ks + (16 * st + kl) * 80 + 16 * seg);
#pragma unroll
        for (int tt = 0; tt < 2; ++tt) Bf[tt] = *(const LAS bf16x8*)(Qs + (16 * tt + kl) * 80 + 16 * seg);
#pragma unroll
        for (int st = 0; st < 2; ++st)
#pragma unroll
            for (int tt = 0; tt < 2; ++tt) sc[st][tt] = __builtin_amdgcn_mfma_f32_16x16x32_bf16(Af[st], Bf[tt], sc[st][tt], 0, 0, 0);
#pragma unroll
        for (int tt = 0; tt < 2; ++tt) { const u32x2 lo = *(const LAS u32x2*)(Qs + (16 * tt + kl) * 80 + 8 * seg), hi = *(const LAS u32x2*)(Qs + (16 * tt + kl) * 80 + 32 + 8 * seg);
            *(u32x4*)(qc + (2 * ks + tt) * 512 + lane * 8) = (u32x4){lo.x, lo.y, hi.x, hi.y}; }
    }
#pragma unroll
    for (int tt = 0; tt < 2; ++tt) { const int t = 16 * tt + kl;
#pragma unroll
        for (int r = 0; r < 4; ++r) { const unsigned pk = cvt_pk_bf16((4 * seg + r <= t) ? sc[0][tt][r] : 0.f, (16 + 4 * seg + r <= t) ? sc[1][tt][r] : 0.f);
            *(LAS bf16_t*)(Qs + t * 80 + (4 * seg + r) * 2) = (bf16_t)(pk & 0xffffu); *(LAS bf16_t*)(Qs + t * 80 + (16 + 4 * seg + r) * 2) = (bf16_t)(pk >> 16); } }
    asm volatile("" ::: "memory");
#pragma unroll
    for (int tt = 0; tt < 2; ++tt) { const u32x4 pf = *(const LAS u32x4*)(Qs + (16 * tt + kl) * 80 + 16 * seg); *(u32x4*)(oi + tt * 512 + lane * 8) = pf; }
}

constexpr int OFF_PRIV = 3 * RING, OFF_OT = OFF_PRIV + 3 * 8 * 2048, OFF_OS = OFF_OT + 2 * 32 * OTP, B_END = OFF_OS + 2 * 32 * OTP;
static_assert(B_END <= 163840, "hgrn pass B lds");
#define HGB_DMA(c, stg) do { const size_t ce_ = (size_t)(cbase + (c)) * 4096; LAS unsigned char* sh_ = lds + (stg) * RING; LAS unsigned char* pv_ = lds + OFF_PRIV + ((stg) * 8 + w) * 2048; \
        __builtin_amdgcn_global_load_lds((const unsigned*)(QF + ce_ + w * 512 + lane * 8), (LAS unsigned*)(sh_ + w * 1024), 16, 0, 0); \
        __builtin_amdgcn_global_load_lds((const unsigned*)(KH + ce_ + w * 512 + lane * 8), (LAS unsigned*)(sh_ + 8192 + w * 1024), 16, 0, 0); \
        __builtin_amdgcn_global_load_lds((const unsigned*)(DC + (size_t)(cbase + (c)) * 256 + lane * 4), (LAS unsigned*)(sh_ + 16384), 16, 0, 0); \
        __builtin_amdgcn_global_load_lds((const unsigned*)(IT + ce_ + (16 * w + kl) * 32 + 8 * seg), (LAS unsigned*)(pv_), 16, 0, 0); \
        __builtin_amdgcn_global_load_lds((const unsigned*)(OI + (size_t)(cbase + (c)) * 1024 + (w & 1) * 512 + lane * 8), (LAS unsigned*)(sh_ + 17408 + (w & 1) * 1024), 16, 0, 0); \
        __builtin_amdgcn_global_load_lds((const unsigned*)(GT + ce_ + w * 512 + lane * 8), (LAS unsigned*)(pv_ + 1024), 16, 0, 0); } while (0)
#define HGB_OUT(c, par_) do { const int t_ = tid >> 4, cc_ = tid & 15; \
        const u32x4 r_ = *(const LAS u32x4*)(lds + OFF_OS + (par_) * 32 * OTP + t_ * OTP + cc_ * 16); \
        const u32x4 v_ = *(const LAS u32x4*)(lds + OFF_OT + (par_) * 32 * OTP + t_ * OTP + cc_ * 16); \
        float ss_ = 0.f; \
        _Pragma("unroll") for (int i_ = 0; i_ < 4; ++i_) { const float lo_ = bf_lo(r_[i_]), hi_ = bf_hi(r_[i_]); ss_ += lo_ * lo_ + hi_ * hi_; } \
        ss_ += row_ror_f(ss_, 0x128); ss_ += row_ror_f(ss_, 0x124); ss_ += row_ror_f(ss_, 0x122); ss_ += row_ror_f(ss_, 0x121);   \
        const float rs_ = rsqrtf(ss_ * (1.f / 128.f) + EPS); u32x4 o_; \
        _Pragma("unroll") for (int i_ = 0; i_ < 4; ++i_) o_[i_] = cvt_pk_bf16(bf_lo(v_[i_]) * rs_, bf_hi(v_[i_]) * rs_); \
          \
        asm volatile("global_store_dwordx4 %0, %1, off\n\ts_nop 1" :: "v"(AO + (size_t)(b * SEQ + (c) * 32 + t_) * D + h * 128 + cc_ * 8), "v"(o_) : "memory"); } while (0)

__device__ __forceinline__ void pass_b_item(LAS unsigned char* lds, int b, int h, const bf16_t* QF, const bf16_t* KH, const bf16_t* IT, const bf16_t* GT, const float* DC, const bf16_t* OI, bf16_t* AO, unsigned* flag, unsigned want) {
    int tid = threadIdx.x; asm volatile("" : "+v"(tid));
    const int lane = tid & 63, w = __builtin_amdgcn_readfirstlane(tid >> 6), kl = lane & 15, seg = lane >> 4;
    const int cbase = (b * 8 + h) * 128, NCH = SEQ / 32;
    f32x4 S[8];
#pragma unroll
    for (int kg = 0; kg < 8; ++kg) S[kg] = (f32x4){0.f, 0.f, 0.f, 0.f};
    HGB_DMA(0, 0); HGB_DMA(1, 1);
    asm volatile("s_waitcnt vmcnt(0)" ::: "memory"); __builtin_amdgcn_s_barrier(); asm volatile("" ::: "memory");
    int sc = 0, s2 = 2;
    for (int n = 0; n < NCH; ++n) {
        if (n == NCH / 2 - 2) {
            if (tid == 0) { unsigned sp = 0; while (__hip_atomic_load(flag, __ATOMIC_RELAXED, __HIP_MEMORY_SCOPE_AGENT) < want) { __builtin_amdgcn_s_sleep(2); if (++sp > (1u << 22)) break; }
                __builtin_amdgcn_fence(__ATOMIC_ACQUIRE, "agent"); asm volatile("s_waitcnt vmcnt(0)" ::: "memory"); }
            WG_BAR();
        }
        if (n + 2 < NCH) HGB_DMA(n + 2, s2);
        if (n > 0) HGB_OUT(n - 1, (n - 1) & 1);
        const LAS unsigned char* st = lds + sc * RING; const LAS unsigned char* pv = lds + OFF_PRIV + (sc * 8 + w) * 2048 + lane * 16;
        bf16x8 Sb[4];
#pragma unroll
        for (int ks = 0; ks < 4; ++ks) { const u32x4 pk = (u32x4){cvt_pk_bf16(S[2 * ks][0], S[2 * ks][1]), cvt_pk_bf16(S[2 * ks][2], S[2 * ks][3]), cvt_pk_bf16(S[2 * ks + 1][0], S[2 * ks + 1][1]), cvt_pk_bf16(S[2 * ks + 1][2], S[2 * ks + 1][3])}; Sb[ks] = __builtin_bit_cast(bf16x8, pk); }
        const u32x4 Gc = *(const LAS u32x4*)(pv + 1024);
        const bf16x8 pf0 = *(const LAS bf16x8*)(st + 17408 + lane * 16), pf1 = *(const LAS bf16x8*)(st + 17408 + 1024 + lane * 16);
        f32x4 o[2];
        bf16x8 qa[8], ka[8]; f32x4 dcv[8];
#pragma unroll
        for (int i = 0; i < 8; ++i) qa[i] = *(const LAS bf16x8*)(st + i * 1024 + lane * 16);
        const bf16x8 Vb = *(const LAS bf16x8*)(pv);
#pragma unroll
        for (int kg = 0; kg < 8; ++kg) { dcv[kg] = *(const LAS f32x4*)(st + 16384 + (16 * kg + 4 * seg) * 4); ka[kg] = *(const LAS bf16x8*)(st + 8192 + kg * 1024 + lane * 16); }
        __builtin_amdgcn_sched_barrier(0);
        { const f32x4 z = (f32x4){0.f, 0.f, 0.f, 0.f}; o[0] = __builtin_amdgcn_mfma_f32_16x16x32_bf16(pf0, Vb, z, 0, 0, 0); o[1] = __builtin_amdgcn_mfma_f32_16x16x32_bf16(pf1, Vb, z, 0, 0, 0); }
#pragma unroll
        for (int ks = 0; ks < 4; ++ks)
#pragma unroll
            for (int tt = 0; tt < 2; ++tt) o[tt] = __builtin_amdgcn_mfma_f32_16x16x32_bf16(qa[2 * ks + tt], Sb[ks], o[tt], 0, 0, 0);
#pragma unroll
        for (int kg = 0; kg < 8; ++kg) S[kg] = __builtin_amdgcn_mfma_f32_16x16x32_bf16(ka[kg], Vb, S[kg] * dcv[kg], 0, 0, 0);
        const int par = n & 1;
#pragma unroll
        for (int tt = 0; tt < 2; ++tt) { const float gv[4] = {bf_lo(Gc[2 * tt]), bf_hi(Gc[2 * tt]), bf_lo(Gc[2 * tt + 1]), bf_hi(Gc[2 * tt + 1])};
#pragma unroll
            for (int r = 0; r < 4; ++r) { const int t = 16 * tt + 4 * seg + r; const unsigned pk = cvt_pk_bf16(o[tt][r], o[tt][r] * gv[r]);
                *(LAS bf16_t*)(lds + OFF_OS + par * 32 * OTP + t * OTP + (16 * w + kl) * 2) = (bf16_t)(pk & 0xffffu);
                *(LAS bf16_t*)(lds + OFF_OT + par * 32 * OTP + t * OTP + (16 * w + kl) * 2) = (bf16_t)(pk >> 16); } }
        if (n + 2 < NCH) asm volatile("s_waitcnt vmcnt(6)" ::: "memory"); else asm volatile("s_waitcnt vmcnt(0)" ::: "memory");
        WG_BAR();
        sc = sc == 2 ? 0 : sc + 1; s2 = s2 == 2 ? 0 : s2 + 1;
    }
    HGB_OUT(NCH - 1, (NCH - 1) & 1);
    asm volatile("s_waitcnt vmcnt(0)" ::: "memory");
    WG_BAR();
}
}

namespace att {
constexpr int KP = 144, VP = 528, OFF_K = 0, OFF_V = 256 * KP;
static_assert(OFF_V + 64 * VP <= 131072, "attn lds");
__device__ __forceinline__ void attn_item(LAS unsigned char* lds, int b, int kvh, int nb, const bf16_t* QB, const bf16_t* KB, const bf16_t* VT, bf16_t* OB, const float* sinks) {
    int tid = threadIdx.x; asm volatile("" : "+v"(tid));
    const int lane = tid & 63, w = __builtin_amdgcn_readfirstlane(tid >> 6), kl = lane & 15, seg = lane >> 4;
    LAS unsigned char* Kl = lds + OFF_K; LAS unsigned char* Vl = lds + OFF_V;
    const int sbase = 128 * (nb - 1);
#pragma unroll
    for (int i = 0; i < 4; ++i) { const int id = tid + 512 * i, row = id >> 3, cchunk = id & 7, s = sbase + row;
        u32x4 v = (u32x4){0u, 0u, 0u, 0u}; if (s >= 0) v = *(const u32x4*)(KB + (size_t)(b * SEQ + s) * 128 + kvh * 64 + cchunk * 8);
        *(LAS u32x4*)(Kl + row * KP + cchunk * 16) = v; }
#pragma unroll
    for (int i = 0; i < 4; ++i) { const int id = tid + 512 * i, d = id >> 5, cchunk = id & 31, key0 = cchunk * 8, blk = nb - 1 + (key0 >> 7);
        u32x4 v = (u32x4){0u, 0u, 0u, 0u}; if (blk >= 0) v = *(const u32x4*)(VT + ((size_t)(((b * 2 + kvh) * 32 + blk) * 64 + d)) * 128 + (key0 & 127));
        *(LAS u32x4*)(Vl + d * VP + cchunk * 16) = v; }
    WG_BAR();
    const int head = kvh * 8 + w;
    const float slope2 = ex2(-0.5f * (float)(head + 1)) * LOG2E, sink2 = sinks[head] * LOG2E;
    for (int qb = 0; qb < 8; ++qb) {
        const size_t rowq = (size_t)(b * SEQ + nb * 128 + 16 * qb + kl);
        bf16x8 qf[2];
#pragma unroll
        for (int ks = 0; ks < 2; ++ks) qf[ks] = *(const bf16x8*)(QB + rowq * D + head * 64 + 32 * ks + 8 * seg);
        const int kt0 = qb < 6 ? qb : 6;
        f32x4 sc[10];
#pragma unroll
        for (int jt = 0; jt < 10; ++jt) { sc[jt] = (f32x4){0.f, 0.f, 0.f, 0.f};
#pragma unroll
            for (int ks = 0; ks < 2; ++ks) { const bf16x8 a = *(const LAS bf16x8*)(Kl + (16 * (kt0 + jt) + kl) * KP + (32 * ks + 8 * seg) * 2); sc[jt] = __builtin_amdgcn_mfma_f32_16x16x32_bf16(a, qf[ks], sc[jt], 0, 0, 0); } }
        const int iq = 16 * qb + kl, dbase = 128 + iq - 16 * kt0 - 4 * seg; const unsigned dlim = nb > 0 ? 127u : (unsigned)iq;
        float mx = -INFINITY;
#pragma unroll
        for (int jt = 0; jt < 10; ++jt)
#pragma unroll
            for (int r = 0; r < 4; ++r) { const int dist = dbase - (16 * jt + r);
                const float v = ((unsigned)dist <= dlim) ? sc[jt][r] - slope2 * (float)dist : -INFINITY; sc[jt][r] = v; mx = fmaxf(mx, v); }
        mx = fmaxf(mx, __shfl_xor(mx, 16)); mx = fmaxf(mx, __shfl_xor(mx, 32)); mx = fmaxf(mx, sink2);
        float sum = 0.f;
#pragma unroll
        for (int jt = 0; jt < 10; ++jt)
#pragma unroll
            for (int r = 0; r < 4; ++r) { const float e = ex2(sc[jt][r] - mx); sc[jt][r] = e; sum += e; }
        sum += __shfl_xor(sum, 16); sum += __shfl_xor(sum, 32);
        const float inv = 1.f / (sum + ex2(sink2 - mx));
        bf16x8 pB[5];
#pragma unroll
        for (int kb = 0; kb < 5; ++kb) { u32x4 pk; pk[0] = cvt_pk_bf16(sc[2 * kb][0], sc[2 * kb][1]); pk[1] = cvt_pk_bf16(sc[2 * kb][2], sc[2 * kb][3]); pk[2] = cvt_pk_bf16(sc[2 * kb + 1][0], sc[2 * kb + 1][1]); pk[3] = cvt_pk_bf16(sc[2 * kb + 1][2], sc[2 * kb + 1][3]);
            pB[kb] = __builtin_bit_cast(bf16x8, pk); }
#pragma unroll
        for (int dt = 0; dt < 4; ++dt) {
            f32x4 o = (f32x4){0.f, 0.f, 0.f, 0.f};
#pragma unroll
            for (int kb = 0; kb < 5; ++kb) { const LAS unsigned char* vp = Vl + (16 * dt + kl) * VP + (16 * (kt0 + 2 * kb) + 4 * seg) * 2;
                const u32x2 lo = *(const LAS u32x2*)(vp), hi = *(const LAS u32x2*)(vp + 32);
                const u32x4 av = (u32x4){lo.x, lo.y, hi.x, hi.y};
                o = __builtin_amdgcn_mfma_f32_16x16x32_bf16(__builtin_bit_cast(bf16x8, av), pB[kb], o, 0, 0, 0); }
            u32x2 wv; wv.x = cvt_pk_bf16(o[0] * inv, o[1] * inv); wv.y = cvt_pk_bf16(o[2] * inv, o[3] * inv);
            *(u32x2*)(OB + rowq * D + head * 64 + 16 * dt + 4 * seg) = wv;
        }
    }
    WG_BAR();
}
}

__device__ __forceinline__ float wave_sum(float v) {
#pragma unroll
    for (int o = 1; o < 64; o <<= 1) v += __shfl_xor(v, o);
    return v;
}
__device__ __forceinline__ void transpose_item(const float* W, int K, int N, bf16_t* WT, int row_off, int mode, const float* gain, int gmask, float scale, LAS float* scr, int item, int lane) {
    const int nblk = N / 32, kb = item / nblk, nb = item % nblk, k0 = 64 * kb, n0 = 32 * nb;
#pragma unroll 8
    for (int i = 0; i < 32; ++i) { const int kk = 2 * i + (lane >> 5); const float gsc = gain ? gain[(k0 + kk) & gmask] * scale : scale; scr[kk * 33 + (lane & 31)] = W[(size_t)(k0 + kk) * N + n0 + (lane & 31)] * gsc; }
    LDS_WAIT(); asm volatile("" ::: "memory");
    const int c = lane & 7;
#pragma unroll
    for (int j = 0; j < 4; ++j) { const int nl = (lane >> 3) + 8 * j, n = n0 + nl; const LAS float* s = scr + (8 * c) * 33 + nl;
        u32x4 o; o.x = cvt_pk_bf16(s[0 * 33], s[1 * 33]); o.y = cvt_pk_bf16(s[2 * 33], s[3 * 33]); o.z = cvt_pk_bf16(s[4 * 33], s[5 * 33]); o.w = cvt_pk_bf16(s[6 * 33], s[7 * 33]);
        int drow; if (mode == 0) drow = row_off + n; else { const int isv = n >= DFF ? 1 : 0, f = n - isv * DFF; drow = 256 * (f >> 7) + 128 * isv + (f & 127); }
        *(u32x4*)(WT + (size_t)drow * K + k0 + 8 * c) = o; }
    LDS_WAIT(); asm volatile("" ::: "memory");
}


#define XB_TMO      128
#define XB_XCNT(j)  (256  + 64 * (j))
#define XB_XSUB(j)  (1280 + 64 * (j))
#define XB_XGEN(j)  (2304 + 64 * (j))
#define XB_TOP      3328
#define XB_TOPGEN   3392
#define XCD_BAR_WORDS 3456
#define XB_SPIN_CAP (1u << 18)
__device__ __forceinline__ unsigned xb_ld(unsigned* p)              { return __hip_atomic_load(p, __ATOMIC_RELAXED, __HIP_MEMORY_SCOPE_AGENT); }
__device__ __forceinline__ unsigned xb_add(unsigned* p, unsigned v) { return __hip_atomic_fetch_add(p, v, __ATOMIC_RELAXED, __HIP_MEMORY_SCOPE_AGENT); }
__device__ __forceinline__ unsigned xb_xcc_id() { return (unsigned)__builtin_amdgcn_s_getreg((3 << 11) | 20) & 0xFu; }
#define XB_SPIN(cond, bar) do { unsigned _sp = 0; while (cond) { __builtin_amdgcn_s_sleep(1); \
    if ((++_sp & 255u) == 0u) { if (xb_ld(&(bar)[XB_TMO])) break; if (_sp > XB_SPIN_CAP) { atomicAdd(&(bar)[XB_TMO], 1u); break; } } } } while (0)
struct XcdBarrier { unsigned* bar; unsigned x; volatile LAS unsigned* st; };
__device__ __forceinline__ XcdBarrier xcd_barrier_post(unsigned* bar, volatile LAS unsigned* st) {
    XcdBarrier b; b.bar = bar; b.x = xb_xcc_id(); b.st = st;
    if (threadIdx.x == 0) (void)xb_add(&bar[XB_XCNT(b.x)], 1u);
    return b;
}
__device__ __forceinline__ void xcd_barrier_complete(unsigned* bar, unsigned x, unsigned& nloc, unsigned& nx) {
    const unsigned G = gridDim.x * gridDim.y * gridDim.z;
    unsigned sum, cnt, mine, sp = 0u;
    for (;;) {
        sum = 0u; cnt = 0u; mine = 0u;
#pragma unroll
        for (unsigned j = 0; j < 16; ++j) { const unsigned c = xb_ld(&bar[XB_XCNT(j)]); sum += c; cnt += (c > 0u) ? 1u : 0u; mine = (j == x) ? c : mine; }
        if (sum == G) break;
        __builtin_amdgcn_s_sleep(1);
        if ((++sp & 255u) == 0u) { if (xb_ld(&bar[XB_TMO])) break; if (sp > XB_SPIN_CAP) { atomicAdd(&bar[XB_TMO], 1u); break; } }
    }
    nloc = mine > 0u ? mine : 1u; nx = cnt > 0u ? cnt : 1u;
}
__device__ __forceinline__ void xcd_barrier(const XcdBarrier& b) {
    asm volatile("s_waitcnt vmcnt(0)" ::: "memory");
    __syncthreads();
    if (threadIdx.x == 0) {
        unsigned* bar = b.bar;
        __builtin_amdgcn_s_waitcnt(0);
        unsigned nloc = b.st[0], nx = b.st[1];
        if (nloc == 0u) { xcd_barrier_complete(bar, b.x, nloc, nx); b.st[0] = nloc; b.st[1] = nx; }
        const unsigned old = xb_add(&bar[XB_XSUB(b.x)], 1u);
        const unsigned gen = old / nloc;
        if (old + 1u == (gen + 1u) * nloc) {
            __builtin_amdgcn_fence(__ATOMIC_RELEASE, "agent");
            asm volatile("s_waitcnt vmcnt(0)" ::: "memory");
            const unsigned og = xb_add(&bar[XB_TOP], 1u);
            const unsigned tg = og / nx;
            if (og + 1u == (tg + 1u) * nx) xb_add(&bar[XB_TOPGEN], 1u);
            else XB_SPIN(xb_ld(&bar[XB_TOPGEN]) == tg, bar);
            __builtin_amdgcn_fence(__ATOMIC_ACQUIRE, "agent");
            xb_add(&bar[XB_XGEN(b.x)], 1u);
            asm volatile("s_waitcnt vmcnt(0)" ::: "memory");
        } else {
            XB_SPIN(xb_ld(&bar[XB_XGEN(b.x)]) == gen, bar);
            __builtin_amdgcn_fence(__ATOMIC_ACQUIRE, "agent");
            asm volatile("s_waitcnt vmcnt(0)" ::: "memory");
        }
    }
    __syncthreads();
}


__device__ __forceinline__ void ffn_fixup(const pg8::StaticOrder& S, bf16_t* Uo, const float* GH, const float* GS, const float* VS, const float* cw, const float* cb) {
    pg8::Unit u;
    for (int i = 0; S.next(i, u); ++i) {
        const int pm = u.pm; if ((pm & 15) == 0) continue;
#pragma unroll
        for (int it = 0; it < 2; ++it) {
            const int q = (int)threadIdx.x + 512 * it;
            if (q < DFF / 4) {
                const int f = 4 * q;
                const f32x4 g254 = *(const f32x4*)(GH + (size_t)((pm - 1) * 2 + 0) * DFF + f), g255 = *(const f32x4*)(GH + (size_t)((pm - 1) * 2 + 1) * DFF + f);
                const f32x4 g0 = *(const f32x4*)(GS + (size_t)(pm * 2 + 0) * DFF + f), g1 = *(const f32x4*)(GS + (size_t)(pm * 2 + 1) * DFF + f);
                const f32x4 v0 = *(const f32x4*)(VS + (size_t)(pm * 2 + 0) * DFF + f), v1 = *(const f32x4*)(VS + (size_t)(pm * 2 + 1) * DFF + f);
                const f32x4 w0 = *(const f32x4*)(cw + f), w1 = *(const f32x4*)(cw + DFF + f), w2 = *(const f32x4*)(cw + 2 * DFF + f), bb = *(const f32x4*)(cb + f);
                const f32x4 c0 = bb + w0 * g254 + w1 * g255 + w2 * g0, c1 = bb + w0 * g255 + w1 * g0 + w2 * g1;
                u32x2 o0, o1;
                o0[0] = cvt_pk_bf16(silu_f(c0[0]) * v0[0], silu_f(c0[1]) * v0[1]); o0[1] = cvt_pk_bf16(silu_f(c0[2]) * v0[2], silu_f(c0[3]) * v0[3]);
                o1[0] = cvt_pk_bf16(silu_f(c1[0]) * v1[0], silu_f(c1[1]) * v1[1]); o1[1] = cvt_pk_bf16(silu_f(c1[2]) * v1[2], silu_f(c1[3]) * v1[3]);
                *(u32x2*)(Uo + (size_t)(pm * 256 + 0) * DFF + f) = o0; *(u32x2*)(Uo + (size_t)(pm * 256 + 1) * DFF + f) = o1;
            }
        }
    }
    asm volatile("s_waitcnt vmcnt(0)" ::: "memory");
    __syncthreads();
}

struct Params {
    const float* in[18];
    float* out; unsigned char* ws;
};

constexpr int LDS_HALO_OFF = 131072;
constexpr int LDS_BYTES = 163840;
constexpr int LDS_XB_OFF = 163328;

__global__ void __launch_bounds__(512, 2) yoco_fwd(Params P) {
    extern __shared__ __attribute__((aligned(16))) unsigned char lds_raw[];
    LAS unsigned char* lds = (LAS unsigned char*)lds_raw;
    cg::grid_group grid = cg::this_grid();
    const int tid = threadIdx.x, lane = tid & 63, wave = __builtin_amdgcn_readfirstlane(tid >> 6);
    const int G = gridDim.x, bx = blockIdx.x;
#define x ((const float*)P.in[0])
#define hg_norm ((const float*)P.in[1])
#define hg_w_in ((const float*)P.in[2])
#define hg_lb ((const float*)P.in[3])
#define hg_out_norm ((const float*)P.in[4])
#define hg_w_out ((const float*)P.in[5])
#define kv_norm ((const float*)P.in[6])
#define w_kv ((const float*)P.in[7])
#define attn_norm ((const float*)P.in[8])
#define attn_w_q ((const float*)P.in[9])
#define attn_sinks ((const float*)P.in[10])
#define attn_w_o ((const float*)P.in[11])
#define ffn_norm ((const float*)P.in[12])
#define ffn_w_up ((const float*)P.in[13])
#define ffn_conv_w ((const float*)P.in[14])
#define ffn_conv_b ((const float*)P.in[15])
#define ffn_w_down ((const float*)P.in[16])
#define final_norm ((const float*)P.in[17])
#define RS ((float*)(P.ws + WS_RS))
#define WinT ((bf16_t*)(P.ws + WS_WIN))
#define WoutT ((bf16_t*)(P.ws + WS_WOUT))
#define WupT0 ((bf16_t*)(P.ws + WS_WUP0))
#define WdT0 ((bf16_t*)(P.ws + WS_WD0))
#define WqkvT ((bf16_t*)(P.ws + WS_WQKV))
#define WoT ((bf16_t*)(P.ws + WS_WO))
#define WupT1 ((bf16_t*)(P.ws + WS_WUP1))
#define WdT1 ((bf16_t*)(P.ws + WS_WD1))
#define HB ((bf16_t*)(P.ws + WS_HB))
#define H ((float*)(P.ws + WS_H))
#define QT ((bf16_t*)(P.ws + WS_QT))
#define FT ((bf16_t*)(P.ws + WS_FT))
#define IT ((bf16_t*)(P.ws + WS_IT))
#define GT ((bf16_t*)(P.ws + WS_GT))
#define AO ((bf16_t*)(P.ws + WS_AO))
#define OI ((bf16_t*)(P.ws + WS_OI))
#define DC ((float*)(P.ws + WS_DC))
#define U ((bf16_t*)(P.ws + WS_U))
#define QB ((bf16_t*)(P.ws + WS_QB))
#define KB ((bf16_t*)(P.ws + WS_KB))
#define VT ((bf16_t*)(P.ws + WS_VT))
#define OB ((bf16_t*)(P.ws + WS_OB))
#define FGH ((float*)(P.ws + WS_H))
#define FGS ((float*)(P.ws + WS_H + 4 * MiB))
#define FVS ((float*)(P.ws + WS_H + 8 * MiB))
    const int gw = bx * 8 + wave, NGW = G * 8;

    {
        LAS float* scr = (LAS float*)(lds + wave * 16384);
        for (int it = gw; it < 16 * 128; it += NGW) transpose_item(hg_w_in, D, 4 * D, WinT, 0, 0, hg_norm, 1023, 1.f, scr, it, lane);
        for (int m = gw; m < M; m += NGW) {
            const f32x4* xr = (const f32x4*)(x + (size_t)m * D) + lane; float s = 0.f;
            unsigned long long* o8 = (unsigned long long*)(HB + (size_t)m * D) + lane;
#pragma unroll
            for (int j = 0; j < 4; ++j) { const f32x4 v = xr[64 * j]; s += (v[0] * v[0] + v[1] * v[1]) + (v[2] * v[2] + v[3] * v[3]);
                o8[64 * j] = (unsigned long long)cvt_pk_bf16(v[0], v[1]) | ((unsigned long long)cvt_pk_bf16(v[2], v[3]) << 32); }
            s = wave_sum(s);
            if (lane == 0) RS[m] = s;
        }
        for (int i = bx * 512 + tid; i < 4 * M; i += G * 512) RS[M + i] = 0.f;
        if (bx == 0) for (int i = tid; i < XCD_BAR_WORDS; i += 512) ((unsigned*)(P.ws + WS_BAR))[i] = 0u;
        if (tid < 2) ((LAS unsigned*)(lds + LDS_XB_OFF))[tid] = 0u;
    }
    grid.sync();
    const XcdBarrier xbar = xcd_barrier_post((unsigned*)(P.ws + WS_BAR), (volatile LAS unsigned*)(lds + LDS_XB_OFF));

    {
        pg8::Gemm g{HB, WinT, M, 4 * D, D}; pg8::StaticOrder S; S.init(M / 256, 16, G, bx, 0);
        pg8::EpiHg E{P.ws, RS, hg_lb};
        pg8::gemm_phase<pg8::EpiHg, true>(lds, g, S, E);
    }
    xcd_barrier(xbar);

    for (int c = gw; c < 4096; c += NGW) hg::pass_a_chunk(lds + wave * hg::A_WAVE_LDS, (c & 63) * 128 + (c >> 6), QT, FT, IT, DC, OI, lane);
    xcd_barrier(xbar);
    unsigned* hgflag = (unsigned*)(P.ws + WS_BAR) + 3424;
    if (bx < 64) { for (int item = bx; item < 64; item += G) hg::pass_b_item(lds, item >> 3, item & 7, QT, FT, IT, GT, DC, OI, AO, hgflag, (unsigned)(G - 64)); }
    else {
        for (int c = (bx - 64) * 8 + wave; c < 4096; c += (G - 64) * 8) hg::pass_a_chunk(lds + wave * hg::A_WAVE_LDS, (c & 63) * 128 + 64 + (c >> 6), QT, FT, IT, DC, OI, lane);
        asm volatile("s_waitcnt vmcnt(0)" ::: "memory"); __syncthreads();
        if (tid == 0) { __builtin_amdgcn_fence(__ATOMIC_RELEASE, "agent"); asm volatile("s_waitcnt vmcnt(0)" ::: "memory"); __hip_atomic_fetch_add(hgflag, 1u, __ATOMIC_RELAXED, __HIP_MEMORY_SCOPE_AGENT); }
        LAS float* scr = (LAS float*)(lds + wave * 16384);
        constexpr int I_SQ = 16 * 32, I_UP = 16 * 176, I_DN = 44 * 32, I_KV = 16 * 8;
        constexpr int NIT = I_SQ + 2 * I_UP + 2 * I_DN + I_SQ + I_KV + I_SQ;
        for (int it = (bx - 64) * 8 + wave; it < NIT; it += (G - 64) * 8) {
            int r = it;
            if (r < I_SQ) { transpose_item(hg_w_out, D, D, WoutT, 0, 0, hg_out_norm, 127, 1.f, scr, r, lane); continue; } r -= I_SQ;
            if (r < I_UP) { transpose_item(ffn_w_up, D, 2 * DFF, WupT0, 0, 1, ffn_norm, 1023, 1.f, scr, r, lane); continue; } r -= I_UP;
            if (r < I_UP) { transpose_item(ffn_w_up + (size_t)D * 2 * DFF, D, 2 * DFF, WupT1, 0, 1, ffn_norm + D, 1023, 1.f, scr, r, lane); continue; } r -= I_UP;
            if (r < I_DN) { transpose_item(ffn_w_down, DFF, D, WdT0, 0, 0, nullptr, 0, 1.f, scr, r, lane); continue; } r -= I_DN;
            if (r < I_DN) { transpose_item(ffn_w_down + (size_t)DFF * D, DFF, D, WdT1, 0, 0, nullptr, 0, 1.f, scr, r, lane); continue; } r -= I_DN;
            if (r < I_SQ) { transpose_item(attn_w_q, D, D, WqkvT, 0, 0, attn_norm, 1023, 0.125f * LOG2E, scr, r, lane); continue; } r -= I_SQ;
            if (r < I_KV) { transpose_item(w_kv, D, 256, WqkvT, 1024, 0, kv_norm, 1023, 1.f, scr, r, lane); continue; } r -= I_KV;
            transpose_item(attn_w_o, D, D, WoT, 0, 0, nullptr, 0, 1.f, scr, r, lane);
        }
    }
    xcd_barrier(xbar);

    {
        pg8::Gemm g{AO, WoutT, M, D, D}; pg8::StaticOrder S; S.init(M / 256, 4, G, bx, 0);
        pg8::EpiRes E{HB, RS + M};
        pg8::gemm_phase<pg8::EpiRes, false, true>(lds, g, S, E);
    }
    xcd_barrier(xbar);

#define FFN_LAYER(layer) do { \
        { pg8::Gemm g{HB, layer == 0 ? WupT0 : WupT1, M, 2 * DFF, D}; pg8::StaticOrder S; S.init(M / 256, 22, G, bx, 0); \
          pg8::EpiFfn E{U, RS + (layer == 0 ? 1 : 3) * M, ffn_conv_w + (size_t)layer * 3 * DFF, ffn_conv_b + (size_t)layer * DFF, (LAS float*)(lds + LDS_HALO_OFF), FGH, FGS, FVS}; \
          pg8::gemm_phase<pg8::EpiFfn, false, true>(lds, g, S, E); } \
        xcd_barrier(xbar); \
        { pg8::Gemm g{U, layer == 0 ? WdT0 : WdT1, M, D, DFF}; pg8::StaticOrder S; S.init(M / 256, 4, G, bx, 0); \
          ffn_fixup(S, U, FGH, FGS, FVS, ffn_conv_w + (size_t)layer * 3 * DFF, ffn_conv_b + (size_t)layer * DFF); \
          pg8::EpiRes E{HB, RS + (layer == 0 ? 2 : 4) * M}; \
          pg8::gemm_phase<pg8::EpiRes, false, true>(lds, g, S, E); } \
        xcd_barrier(xbar); } while (0)

    FFN_LAYER(0);
    {
        pg8::Gemm g{HB, WqkvT, M, 1280, D}; pg8::StaticOrder S; S.init(M / 256, 5, G, bx, 0);
        pg8::EpiQkv E{QB, KB, VT, RS + 2 * M};
        pg8::gemm_phase<pg8::EpiQkv, false, true>(lds, g, S, E);
    }
    xcd_barrier(xbar);
    for (int item = bx; item < 512; item += G) { const int nb = item & 31, kvh = (item >> 5) & 1, b = item >> 6; att::attn_item(lds, b, kvh, nb, QB, KB, VT, OB, attn_sinks); }
    xcd_barrier(xbar);
    {
        pg8::Gemm g{OB, WoT, M, D, D}; pg8::StaticOrder S; S.init(M / 256, 4, G, bx, 0);
        pg8::EpiRes E{HB, RS + 3 * M};
        pg8::gemm_phase<pg8::EpiRes, false, true>(lds, g, S, E);
    }
    xcd_barrier(xbar);
    FFN_LAYER(1);

    for (int m = gw; m < M; m += 2 * NGW) {
        const int m2 = (m + NGW < M) ? m + NGW : m;
        const float ra = RS[4 * M + m], rb = RS[4 * M + m2];
        const u32x2* hrow = (const u32x2*)(HB + (size_t)m * D) + lane; const u32x2* hrow2 = (const u32x2*)(HB + (size_t)m2 * D) + lane;
        u32x2 ha[4], hb2[4];
#pragma unroll
        for (int j = 0; j < 4; ++j) { ha[j] = hrow[64 * j]; hb2[j] = hrow2[64 * j]; }
        const float rs = rsqrtf(ra * (1.f / D) + EPS), rs2 = rsqrtf(rb * (1.f / D) + EPS);
        f32x4* orow = (f32x4*)(P.out + (size_t)m * D) + lane; f32x4* orow2 = (f32x4*)(P.out + (size_t)m2 * D) + lane; const f32x4* gn = (const f32x4*)final_norm + lane;
#pragma unroll
        for (int j = 0; j < 4; ++j) { const f32x4 gj = gn[64 * j];
            const f32x4 v = (f32x4){bf_lo(ha[j][0]), bf_hi(ha[j][0]), bf_lo(ha[j][1]), bf_hi(ha[j][1])}; orow[64 * j] = v * rs * gj;
            if (m2 != m) { const f32x4 w2 = (f32x4){bf_lo(hb2[j][0]), bf_hi(hb2[j][0]), bf_lo(hb2[j][1]), bf_hi(hb2[j][1])}; orow2[64 * j] = w2 * rs2 * gj; } }
    }
}

extern "C" void kernel_launch(void* const* d_in, const int* in_sizes, int n_in, void* d_out, int out_size, void* d_ws, size_t ws_size, hipStream_t stream) {
    static int grid_blocks = 0;
    if (grid_blocks == 0) {
        if (n_in != 18 || in_sizes[0] != M * D || out_size != M * D || ws_size < WS_END) { fprintf(stderr, "kernel_launch: unexpected shapes (n_in %d, in0 %d, out %d, ws %zu)\n", n_in, n_in > 0 ? in_sizes[0] : -1, out_size, ws_size); grid_blocks = -1; return; }
        int dev = 0, cus = 0, per_cu = 0;
        hipGetDevice(&dev);
        hipDeviceGetAttribute(&cus, hipDeviceAttributeMultiprocessorCount, dev);
        hipFuncSetAttribute((const void*)yoco_fwd, hipFuncAttributeMaxDynamicSharedMemorySize, LDS_BYTES);
        hipOccupancyMaxActiveBlocksPerMultiprocessor(&per_cu, (const void*)yoco_fwd, 512, LDS_BYTES);
        if (per_cu < 1) { fprintf(stderr, "kernel_launch: occupancy query says %d blocks per CU\n", per_cu); grid_blocks = -1; return; }
        grid_blocks = cus;
    }
    if (grid_blocks < 0) return;
    Params p{};
    for (int i = 0; i < 18; ++i) p.in[i] = (const float*)d_in[i];
    p.out = (float*)d_out; p.ws = (unsigned char*)d_ws;
    void* args[] = {&p};
    hipError_t e = hipLaunchCooperativeKernel((const void*)yoco_fwd, dim3(grid_blocks), dim3(512), args, LDS_BYTES, stream);
    if (e != hipSuccess) fprintf(stderr, "cooperative launch failed: %s (grid %d)\n", hipGetErrorString(e), grid_blocks);
}
```

```cpp
#include <hip/hip_runtime.h>
#include <hip/hip_cooperative_groups.h>
#include <cstdio>
#include <cstdint>
namespace cg = cooperative_groups;

#define LAS __attribute__((address_space(3)))
typedef unsigned short bf16_t;
typedef short bf16x8 __attribute__((ext_vector_type(8)));
typedef short s16x4 __attribute__((ext_vector_type(4)));
typedef float f32x4 __attribute__((ext_vector_type(4)));
typedef unsigned u32x4 __attribute__((ext_vector_type(4)));
typedef unsigned u32x2 __attribute__((ext_vector_type(2)));

constexpr int D = 1024, BATCH = 8, SEQ = 4096, M = BATCH * SEQ, DFF = 2816;
constexpr float EPS = 1e-6f;
constexpr float LOG2E = 1.4426950408889634f;

constexpr size_t MiB = 1u << 20;
constexpr size_t WS_RS = 0;
constexpr size_t WS_BAR = 768 * 1024;
constexpr size_t WS_WIN = 1 * MiB, WS_WOUT = 9 * MiB, WS_WUP0 = 11 * MiB, WS_WD0 = 22 * MiB, WS_WQKV = 28 * MiB, WS_WO = 31 * MiB, WS_WUP1 = 33 * MiB, WS_WD1 = 44 * MiB;
constexpr size_t WS_HB = 51 * MiB;
constexpr size_t WS_H = 116 * MiB;
constexpr size_t WS_T = 244 * MiB;
constexpr size_t WS_QT = WS_T, WS_FT = WS_T + 64 * MiB, WS_IT = WS_T + 128 * MiB, WS_AO = WS_T + 192 * MiB, WS_GT = WS_H, WS_OI = WS_H + 64 * MiB, WS_DC = WS_T + 256 * MiB;
constexpr size_t WS_U = WS_T;
constexpr size_t WS_QB = WS_T, WS_KB = WS_T + 64 * MiB, WS_VT = WS_T + 72 * MiB, WS_OB = WS_T + 80 * MiB;
constexpr size_t WS_END = 512 * MiB;

typedef float f32x2_t __attribute__((ext_vector_type(2))); typedef __bf16 bf16x2_t __attribute__((ext_vector_type(2)));
__device__ __forceinline__ unsigned cvt_pk_bf16(float lo, float hi) { const f32x2_t v = {lo, hi}; const bf16x2_t r = __builtin_convertvector(v, bf16x2_t); return __builtin_bit_cast(unsigned, r); }
__device__ __forceinline__ bf16_t f2bf(float f) { return (bf16_t)(cvt_pk_bf16(f, 0.f) & 0xffffu); }
__device__ __forceinline__ float bf_lo(unsigned u) { return __uint_as_float(u << 16); }
__device__ __forceinline__ float bf_hi(unsigned u) { return __uint_as_float(u & 0xffff0000u); }
__device__ __forceinline__ float ex2(float x) { return __builtin_amdgcn_exp2f(x); }
__device__ __forceinline__ float rcpf_(float x) { return __builtin_amdgcn_rcpf(x); }
__device__ __forceinline__ float sigmoid_f(float v) { return rcpf_(1.f + ex2(-LOG2E * v)); }
__device__ __forceinline__ float silu_f(float v) { return v * sigmoid_f(v); }
template <int CTRL> __device__ __forceinline__ float row_ror_t(float v) { return __builtin_bit_cast(float, __builtin_amdgcn_update_dpp(0, __builtin_bit_cast(int, v), CTRL, 0xf, 0xf, false)); }
#define row_ror_f(v, ctrl) row_ror_t<ctrl>(v)
#define LDS_WAIT() asm volatile("s_waitcnt lgkmcnt(0)" ::: "memory")
#define WG_BAR() do { asm volatile("s_waitcnt lgkmcnt(0)" ::: "memory"); __builtin_amdgcn_s_barrier(); asm volatile("" ::: "memory"); } while (0)

namespace pg8 {
constexpr int BM = 256, BK = 64, HALF = 128, HTB = HALF * BK * 2, STAGE_BYTES = 8 * HTB, NXCD = 8, WGM = 8;
__host__ __device__ __forceinline__ int lds_byte(int r, int c) { const int st = (r >> 4) * 2 + (c >> 5), rr = r & 15, cc = c & 31, ob = rr * 64 + cc * 2; return st * 1024 + (ob ^ (((ob >> 9) & 1) << 5)); }
__host__ __device__ __forceinline__ int perm32(int rho) { const int n = rho >> 4, i = rho & 15; return 8 * (i >> 2) + 4 * n + (i & 3); }
__host__ __device__ __forceinline__ void stage_rc(int b, int& R, int& C) { const int st = b / 1024, sb = b % 1024, swz = sb ^ (((sb >> 9) & 1) << 5); R = (st >> 1) * 16 + swz / 64; C = (st & 1) * 32 + (swz % 64) / 2; }

struct Unit { int pm, pn, arow; };
struct Gemm { const bf16_t* A; const bf16_t* Bt; int M, N, K; };

struct StaticOrder {
    int nM, nN, nwg, G, c, ovl;
    __device__ void init(int nM_, int nN_, int G_, int c_, int ovl_) { nM = nM_; nN = nN_; nwg = nM * nN; G = G_; c = c_; ovl = ovl_; }
    __device__ bool next(int i, Unit& u) const {
        const long L = (long)i * G + c; if (L >= nwg) return false;
        int wgid = (int)L; { const int q = nwg / NXCD, r = nwg % NXCD, xcd = wgid % NXCD, off = wgid / NXCD; wgid = (xcd < r ? xcd * (q + 1) : r * (q + 1) + (xcd - r) * q) + off; }
        const int nig = WGM * nN, gid = wgid / nig, fm = gid * WGM, gsz = (nM - fm) < WGM ? (nM - fm) : WGM;
        u.pm = fm + ((wgid % nig) % gsz); u.pn = (wgid % nig) / gsz;
        u.arow = ovl ? (u.pm / 17) * SEQ + 254 * (u.pm % 17) - 2 : u.pm * BM;
        return true;
    }
};

template <class Epi, bool SWAP, bool PERM = false>
__device__ __forceinline__ void gemm_phase(LAS unsigned char* lds, const Gemm g, const StaticOrder& S, const Epi& E) {
    int tid = threadIdx.x; asm volatile("" : "+v"(tid));
    const int wid = __builtin_amdgcn_readfirstlane(tid >> 6), lane = tid & 63, wr = wid >> 2, wc = wid & 3, fr = lane & 15, fq = lane >> 4;
    const int K = g.K, nt = K / BK;
    unsigned voffA[2], voffB[2];
#pragma unroll
    for (int i = 0; i < 2; ++i) { int R, C; stage_rc(tid * 16 + i * 8192, R, C); voffA[i] = (unsigned)(R * K + C) * 2u; const int Rb = PERM ? ((R & ~31) + perm32(R & 31)) : R; voffB[i] = (unsigned)(Rb * K + C) * 2u; }
    const size_t kstep = (size_t)(BK * 2);
    const size_t hstep = (size_t)HALF * K * 2;
    const size_t tstep = 2 * hstep;
    const long rowb = (long)K * 2;
    const unsigned ldsw = (unsigned)wid * 1024u;
    const int aoff = lds_byte(wr * 64 + fr, fq * 8), boff = lds_byte(wc * 32 + fr, fq * 8);
#define PG8_SA(b, h) (((b) * 2 + (h)) * HTB)
#define PG8_SB(b, h) ((4 + (b) * 2 + (h)) * HTB)
#define PG8_STAGE(bufoff, gbase, voff) do { _Pragma("unroll") for (int _i = 0; _i < 2; ++_i) \
        __builtin_amdgcn_global_load_lds((const unsigned*)((const char*)(gbase) + (voff)[_i]), (LAS unsigned*)(lds + (bufoff) + ldsw + _i * 8192), 16, 0, 0); } while (0)
#define PG8_LDA(dst, b, h) do { _Pragma("unroll") for (int m = 0; m < 4; ++m) _Pragma("unroll") for (int k = 0; k < 2; ++k) dst[m][k] = *(const LAS bf16x8*)(lds + PG8_SA(b, h) + aoff + m * 2048 + k * 1024); } while (0)
#define PG8_LDB(dst, b, h) do { _Pragma("unroll") for (int n = 0; n < 2; ++n) _Pragma("unroll") for (int k = 0; k < 2; ++k) dst[n][k] = *(const LAS bf16x8*)(lds + PG8_SB(b, h) + boff + n * 2048 + k * 1024); } while (0)
#define PG8_MMA(ai, bj, At, Bt) do { __builtin_amdgcn_s_setprio(1); _Pragma("unroll") for (int m = 0; m < 4; ++m) _Pragma("unroll") for (int n = 0; n < 2; ++n) _Pragma("unroll") for (int k = 0; k < 2; ++k) { \
        if constexpr (SWAP) acc[ai][bj][m][n] = __builtin_amdgcn_mfma_f32_16x16x32_bf16(At[m][k], Bt[n][k], acc[ai][bj][m][n], 0, 0, 0); \
        else acc[ai][bj][m][n] = __builtin_amdgcn_mfma_f32_16x16x32_bf16(Bt[n][k], At[m][k], acc[ai][bj][m][n], 0, 0, 0); } __builtin_amdgcn_s_setprio(0); } while (0)
#define PG8_WAIT_V(n) asm volatile("s_waitcnt vmcnt(" #n ")" ::: "memory")
#define PG8_WAIT_L(n) asm volatile("s_waitcnt lgkmcnt(" #n ")" ::: "memory")
#define PG8_BAR __builtin_amdgcn_s_barrier()
#define PG8_SCHED __builtin_amdgcn_sched_barrier(0)
    Unit cur, nxt; int ui = 0;
    if (!S.next(0, cur)) return;
    f32x4 acc[2][2][4][2];
#pragma unroll
    for (int a = 0; a < 2; ++a)
#pragma unroll
        for (int b = 0; b < 2; ++b)
#pragma unroll
            for (int m = 0; m < 4; ++m)
#pragma unroll
                for (int n = 0; n < 2; ++n) acc[a][b][m][n] = (f32x4){0.f, 0.f, 0.f, 0.f};
    bf16x8 At[4][2], B0[2][2], B1[2][2];
    const char* cA = (const char*)g.A + (long)cur.arow * rowb; const char* cB = (const char*)g.Bt + (size_t)cur.pn * tstep;
    PG8_STAGE(PG8_SB(0, 0), cB, voffB); PG8_STAGE(PG8_SB(0, 1), cB + hstep, voffB); PG8_STAGE(PG8_SA(0, 0), cA, voffA); PG8_STAGE(PG8_SA(0, 1), cA + hstep, voffA);
    if (wr == 1) PG8_BAR;
    PG8_WAIT_V(2); PG8_BAR;
    PG8_STAGE(PG8_SB(1, 0), cB + kstep, voffB); PG8_STAGE(PG8_SA(1, 0), cA + kstep, voffA); PG8_STAGE(PG8_SB(1, 1), cB + hstep + kstep, voffB);
    PG8_WAIT_V(6); PG8_BAR;
    for (;;) {
        const bool has_next = S.next(ui + 1, nxt);
        const char* nA = has_next ? (const char*)g.A + (long)nxt.arow * rowb : cA; const char* nB = has_next ? (const char*)g.Bt + (size_t)nxt.pn * tstep : cB;
        for (int t = 0; t < nt; t += 2) {
            const bool last = (t == nt - 2);
            const char* a1 = cA + (size_t)(t + 1) * kstep;
            const char* a2 = last ? nA : cA + (size_t)(t + 2) * kstep; const char* b2 = last ? nB : cB + (size_t)(t + 2) * kstep;
            const char* a3 = a2 + kstep; const char* b3 = b2 + kstep;
            PG8_LDB(B0, 0, 0); PG8_LDB(B1, 0, 1); PG8_SCHED; PG8_LDA(At, 0, 0); PG8_STAGE(PG8_SA(1, 1), a1 + hstep, voffA);
            PG8_WAIT_V(8); PG8_WAIT_L(0); PG8_BAR; PG8_MMA(0, 0, At, B0); PG8_MMA(0, 1, At, B1); PG8_BAR; PG8_SCHED;
            PG8_LDA(At, 0, 1); PG8_STAGE(PG8_SB(0, 0), b2, voffB); PG8_STAGE(PG8_SB(0, 1), b2 + hstep, voffB); PG8_STAGE(PG8_SA(0, 0), a2, voffA);
            PG8_WAIT_V(8); PG8_WAIT_L(0); PG8_BAR; PG8_MMA(1, 0, At, B0); PG8_MMA(1, 1, At, B1); PG8_BAR; PG8_SCHED;
            PG8_LDB(B0, 1, 0); PG8_LDB(B1, 1, 1); PG8_SCHED; PG8_LDA(At, 1, 0); PG8_STAGE(PG8_SA(0, 1), a2 + hstep, voffA);
            PG8_WAIT_V(8); PG8_WAIT_L(0); PG8_BAR; PG8_MMA(0, 0, At, B0); PG8_MMA(0, 1, At, B1); PG8_BAR; PG8_SCHED;
            PG8_LDA(At, 1, 1); PG8_STAGE(PG8_SB(1, 0), b3, voffB); PG8_STAGE(PG8_SB(1, 1), b3 + hstep, voffB); PG8_STAGE(PG8_SA(1, 0), a3, voffA);
            PG8_WAIT_V(8); PG8_WAIT_L(0); PG8_BAR; PG8_MMA(1, 0, At, B0); PG8_MMA(1, 1, At, B1); PG8_BAR; PG8_SCHED;
        }
        if (wr == 0) PG8_BAR;
        E(acc, cur, wr, wc, fr, fq);
        if (!has_next) break;
#pragma unroll
        for (int a = 0; a < 2; ++a)
#pragma unroll
            for (int b = 0; b < 2; ++b)
#pragma unroll
                for (int m = 0; m < 4; ++m)
#pragma unroll
                    for (int n = 0; n < 2; ++n) acc[a][b][m][n] = (f32x4){0.f, 0.f, 0.f, 0.f};
        cur = nxt; cA = nA; cB = nB; ++ui;
        if (wr == 1) PG8_BAR;
    }
    PG8_WAIT_V(0);
    PG8_BAR;
#undef PG8_SA
#undef PG8_SB
#undef PG8_STAGE
#undef PG8_LDA
#undef PG8_LDB
#undef PG8_MMA
#undef PG8_WAIT_V
#undef PG8_WAIT_L
#undef PG8_BAR
#undef PG8_SCHED
}


struct EpiRes {
    bf16_t* hb; float* rowss;
    __device__ __forceinline__ void operator()(const f32x4 (&acc)[2][2][4][2], const Unit& u, int wr, int wc, int fr, int fq) const {
#pragma unroll
        for (int ai = 0; ai < 2; ++ai)
#pragma unroll
            for (int m = 0; m < 4; ++m) {
                const int row = u.pm * BM + ai * HALF + wr * 64 + m * 16 + fr; float ss = 0.f;
#pragma unroll
                for (int bj = 0; bj < 2; ++bj) {
                    const size_t off = (size_t)row * D + u.pn * BM + bj * HALF + wc * 32 + 8 * fq;
                    const u32x4 hv = *(const u32x4*)(hb + off);
                    f32x4 v0 = acc[ai][bj][m][0], v1 = acc[ai][bj][m][1];
                    v0[0] += bf_lo(hv[0]); v0[1] += bf_hi(hv[0]); v0[2] += bf_lo(hv[1]); v0[3] += bf_hi(hv[1]);
                    v1[0] += bf_lo(hv[2]); v1[1] += bf_hi(hv[2]); v1[2] += bf_lo(hv[3]); v1[3] += bf_hi(hv[3]);
                    *(u32x4*)(hb + off) = (u32x4){cvt_pk_bf16(v0[0], v0[1]), cvt_pk_bf16(v0[2], v0[3]), cvt_pk_bf16(v1[0], v1[1]), cvt_pk_bf16(v1[2], v1[3])};
                    ss += ((v0[0] * v0[0] + v0[1] * v0[1]) + (v0[2] * v0[2] + v0[3] * v0[3])) + ((v1[0] * v1[0] + v1[1] * v1[1]) + (v1[2] * v1[2] + v1[3] * v1[3]));
                }
                ss += __shfl_xor(ss, 16); ss += __shfl_xor(ss, 32);
                if (fq == 0) unsafeAtomicAdd(rowss + row, ss);
                asm volatile("" ::: "memory");
            }
    }
};

struct EpiQkv {
    bf16_t* QB; bf16_t* KB; bf16_t* VT; const float* rowss;
    __device__ __forceinline__ void operator()(const f32x4 (&acc)[2][2][4][2], const Unit& u, int wr, int wc, int fr, int fq) const {
#pragma unroll
        for (int ai = 0; ai < 2; ++ai)
#pragma unroll
            for (int m = 0; m < 4; ++m) {
                const int row = u.pm * BM + ai * HALF + wr * 64 + m * 16 + fr;
                const float rs = rsqrtf(rowss[row] * (1.f / D) + EPS);
#pragma unroll
                for (int bj = 0; bj < 2; ++bj) {
                    const f32x4 v0 = acc[ai][bj][m][0] * rs, v1 = acc[ai][bj][m][1] * rs; const int cl = wc * 32 + 8 * fq;
                    const u32x4 w = (u32x4){cvt_pk_bf16(v0[0], v0[1]), cvt_pk_bf16(v0[2], v0[3]), cvt_pk_bf16(v1[0], v1[1]), cvt_pk_bf16(v1[2], v1[3])};
                    if (u.pn < 4) *(u32x4*)(QB + (size_t)row * D + u.pn * BM + bj * HALF + cl) = w;
                    else if (bj == 0) *(u32x4*)(KB + (size_t)row * 128 + cl) = w;
                    else { const int b = row >> 12, s = row & (SEQ - 1);
#pragma unroll
                        for (int e = 0; e < 8; ++e) { const int c = cl + e; const float ve = e < 4 ? v0[e & 3] : v1[e & 3];
                            VT[((size_t)(((b * 2 + (c >> 6)) * 32 + (s >> 7)) * 64 + (c & 63))) * 128 + (s & 127)] = f2bf(ve); } }
                }
            }
    }
};

struct EpiHg {
    unsigned char* wsb; const float* rowss; const float* lbl;
    __device__ __forceinline__ void operator()(const f32x4 (&acc)[2][2][4][2], const Unit& u, int wr, int wc, int fr, int fq) const {
        const int sec = u.pn >> 2, b = u.pm >> 4, sb = (u.pm & 15) * BM;
        bf16_t* Tp = (bf16_t*)(wsb + (sec == 3 ? WS_GT : WS_QT + (size_t)sec * (64 * MiB)));
        f32x4 ssall[2][4];
#pragma unroll
        for (int ai = 0; ai < 2; ++ai)
#pragma unroll
            for (int m = 0; m < 4; ++m) ssall[ai][m] = *(const f32x4*)(rowss + u.pm * BM + ai * HALF + wr * 64 + m * 16 + 4 * fq);
        float l0[2][2], l1[2][2];
#pragma unroll
        for (int bj = 0; bj < 2; ++bj)
#pragma unroll
            for (int n = 0; n < 2; ++n) { const int c1 = (u.pn & 3) * BM + bj * HALF + wc * 32 + n * 16 + fr; l0[bj][n] = lbl[c1]; l1[bj][n] = lbl[D + c1]; }
        asm volatile("" ::: "memory");
        float lbv[2][2];
#pragma unroll
        for (int bj = 0; bj < 2; ++bj)
#pragma unroll
            for (int n = 0; n < 2; ++n) lbv[bj][n] = rcpf_(1.f + ex2(LOG2E * (l1[bj][n] - l0[bj][n])));
#pragma unroll
        for (int ai = 0; ai < 2; ++ai)
#pragma unroll
            for (int m = 0; m < 4; ++m) {
                const int rl = ai * HALF + wr * 64 + m * 16 + 4 * fq;
                const f32x4 ssv = ssall[ai][m];
                f32x4 rs; rs[0] = rsqrtf(ssv[0] * (1.f / D) + EPS); rs[1] = rsqrtf(ssv[1] * (1.f / D) + EPS); rs[2] = rsqrtf(ssv[2] * (1.f / D) + EPS); rs[3] = rsqrtf(ssv[3] * (1.f / D) + EPS);
#pragma unroll
                for (int bj = 0; bj < 2; ++bj)
#pragma unroll
                    for (int n = 0; n < 2; ++n) {
                        f32x4 v = acc[ai][bj][m][n] * rs;
                        if (sec == 0) { v[0] = silu_f(v[0]) * 0.08838834764831845f; v[1] = silu_f(v[1]) * 0.08838834764831845f; v[2] = silu_f(v[2]) * 0.08838834764831845f; v[3] = silu_f(v[3]) * 0.08838834764831845f; }
                        else if (sec == 1) { const float lb = lbv[bj][n], om = 1.f - lb;
#pragma unroll
                            for (int e = 0; e < 4; ++e) v[e] = om * sigmoid_f(-v[e]); (void)lb; }
                        else if (sec == 3) { v[0] = silu_f(v[0]); v[1] = silu_f(v[1]); v[2] = silu_f(v[2]); v[3] = silu_f(v[3]); }
                        const int head = 2 * (u.pn & 3) + bj, c = wc * 32 + n * 16 + fr;
                        u32x2 w; w.x = cvt_pk_bf16(v[0], v[1]); w.y = cvt_pk_bf16(v[2], v[3]);
                        { const int sa = sb + rl; bf16_t* cb = Tp + ((size_t)((b * 8 + head) * 128 + (sa >> 5))) * 4096;
                          if (sec == 3) *(u32x2*)(cb + (2 * wc + n) * 512 + (fq * 16 + fr) * 8 + (m & 1) * 4) = w;
                          else *(u32x2*)(cb + c * 32 + (sa & 31)) = w; }
                    }
            }
    }
};

struct EpiFfn {
    bf16_t* U; const float* rowss; const float* cw; const float* cb; LAS float* halo; float* GH; float* GS; float* VS;
    __device__ __forceinline__ void operator()(f32x4 (&acc)[2][2][4][2], const Unit& u, int wr, int wc, int fr, int fq) const {
        const int t0 = (u.pm & 15) * BM, lane = fr + 16 * fq; const bool first = t0 == 0;
#pragma unroll
        for (int ai = 0; ai < 2; ++ai)
#pragma unroll
            for (int m = 0; m < 4; ++m) {
                const float rs = rsqrtf(rowss[u.pm * BM + ai * HALF + wr * 64 + m * 16 + fr] * (1.f / D) + EPS);
#pragma unroll
                for (int bj = 0; bj < 2; ++bj)
#pragma unroll
                    for (int n = 0; n < 2; ++n) acc[ai][bj][m][n] = acc[ai][bj][m][n] * rs;
            }
        if (fr >= 14) {
#pragma unroll
            for (int ai = 0; ai < 2; ++ai)
#pragma unroll
                for (int n = 0; n < 2; ++n) *(LAS f32x4*)(halo + ((2 * ai + wr) * 2 + (15 - fr)) * 128 + wc * 32 + 8 * fq + 4 * n) = acc[ai][0][3][n];
        }
        WG_BAR();
        u32x2 keep[2][4];
#pragma unroll
        for (int n = 0; n < 2; ++n) {
            const int f0 = u.pn * 128 + wc * 32 + 8 * fq + 4 * n;
            const f32x4 w0 = *(const f32x4*)(cw + f0), w1 = *(const f32x4*)(cw + DFF + f0), w2 = *(const f32x4*)(cw + 2 * DFF + f0), bb = *(const f32x4*)(cb + f0);
#pragma unroll
            for (int ai = 0; ai < 2; ++ai) {
                const int blk = 2 * ai + wr;
                f32x4 h1 = (f32x4){0.f, 0.f, 0.f, 0.f}, h2 = h1;
                if (blk > 0) { h1 = *(const LAS f32x4*)(halo + ((blk - 1) * 2 + 0) * 128 + wc * 32 + 8 * fq + 4 * n); h2 = *(const LAS f32x4*)(halo + ((blk - 1) * 2 + 1) * 128 + wc * 32 + 8 * fq + 4 * n); }
                f32x4 r1p = h1, r2p = h2;
#pragma unroll
                for (int m = 0; m < 4; ++m) {
                    const f32x4 g = acc[ai][0][m][n];
                    f32x4 r1, r2;
#pragma unroll
                    for (int e = 0; e < 4; ++e) { r1[e] = row_ror_f(g[e], 0x121); r2[e] = row_ror_f(g[e], 0x122); }
                    f32x4 p1, p2;
                    if (m == 0) {
#pragma unroll
                        for (int e = 0; e < 4; ++e) { p1[e] = fr >= 1 ? r1[e] : h1[e]; p2[e] = fr >= 2 ? r2[e] : (fr == 1 ? h1[e] : h2[e]); }
                    } else {
#pragma unroll
                        for (int e = 0; e < 4; ++e) { p1[e] = fr >= 1 ? r1[e] : r1p[e]; p2[e] = fr >= 2 ? r2[e] : r2p[e]; }
                    }
                    r1p = r1; r2p = r2;
                    const int rl = ai * HALF + wr * 64 + m * 16 + fr, t = t0 + rl;
                    if (t < 1) p1 = (f32x4){0.f, 0.f, 0.f, 0.f};
                    if (t < 2) p2 = (f32x4){0.f, 0.f, 0.f, 0.f};
                    const f32x4 cv = bb + w0 * p2 + w1 * p1 + w2 * g;
                    const f32x4 vv = acc[ai][1][m][n];
                    f32x4 o; o[0] = silu_f(cv[0]) * vv[0]; o[1] = silu_f(cv[1]) * vv[1]; o[2] = silu_f(cv[2]) * vv[2]; o[3] = silu_f(cv[3]) * vv[3];
                    if (rl >= 2 || first) { u32x2 w; w[0] = cvt_pk_bf16(o[0], o[1]); w[1] = cvt_pk_bf16(o[2], o[3]);
                        if (n == 0) keep[ai][m] = w; else *(u32x4*)(U + (size_t)(u.pm * BM + rl) * DFF + f0 - 4) = (u32x4){keep[ai][m][0], keep[ai][m][1], w[0], w[1]}; }
                    else { *(f32x4*)(GS + (size_t)(u.pm * 2 + rl) * DFF + f0) = g; *(f32x4*)(VS + (size_t)(u.pm * 2 + rl) * DFF + f0) = vv; }
                    if (rl >= 254) *(f32x4*)(GH + (size_t)(u.pm * 2 + rl - 254) * DFF + f0) = g;
                }
            }
        }
    }
};
}

namespace hg {
constexpr int A_WAVE_LDS = 5120;
constexpr int RING = 19456, OTP = 272;
static_assert(8 * A_WAVE_LDS <= 131072, "hgrn lds");

__device__ __forceinline__ void pass_a_chunk(LAS unsigned char* ldsw, int cidx, bf16_t* QT, bf16_t* FT, const bf16_t* IT, float* DC, bf16_t* OI, int lane) {
    const int kl = lane & 15, seg = lane >> 4;
    bf16_t* qc = QT + (size_t)cidx * 4096; bf16_t* fc = FT + (size_t)cidx * 4096; (void)IT;
    float* dc = DC + (size_t)cidx * 256; bf16_t* oi = OI + (size_t)cidx * 1024;
    LAS unsigned char* Qs = ldsw; LAS unsigned char* Ks = ldsw + 2560;
    f32x4 sc[2][2];
#pragma unroll
    for (int a = 0; a < 2; ++a)
#pragma unroll
        for (int b = 0; b < 2; ++b) sc[a][b] = (f32x4){0.f, 0.f, 0.f, 0.f};
    u32x4 qall[8], fall[8];
#pragma unroll
    for (int kg = 0; kg < 8; ++kg) { qall[kg] = *(const u32x4*)(qc + (16 * kg + kl) * 32 + 8 * seg); fall[kg] = *(const u32x4*)(fc + (16 * kg + kl) * 32 + 8 * seg); }
#pragma unroll
    for (int ks = 0; ks < 4; ++ks) {
#pragma unroll
        for (int kgl = 0; kgl < 2; ++kgl) {
            const int kg = 2 * ks + kgl;
            const u32x4 qv4 = qall[kg], fv4 = fall[kg];
            float kk[8], qv[8];
#pragma unroll
            for (int i = 0; i < 4; ++i) { kk[2 * i] = bf_lo(fv4[i]); kk[2 * i + 1] = bf_hi(fv4[i]); qv[2 * i] = bf_lo(qv4[i]); qv[2 * i + 1] = bf_hi(qv4[i]); }
            float pr[8]; float p = 1.f;
#pragma unroll
            for (int j = 0; j < 8; ++j) { p *= (1.f - kk[j]); pr[j] = p; }
            const float t0 = __shfl(p, kl), t1 = __shfl(p, kl + 16), t2 = __shfl(p, kl + 32), t3 = __shfl(p, kl + 48);
            const float offs = (seg > 0 ? t0 : 1.f) * (seg > 1 ? t1 : 1.f) * (seg > 2 ? t2 : 1.f), dC = (t0 * t1) * (t2 * t3);
            float kh[8];
#pragma unroll
            for (int j = 0; j < 8; ++j) { const float e = pr[j] * offs, kt = kk[j] * rcpf_(e); kh[j] = kt * dC;
                *(LAS bf16_t*)(Qs + (8 * seg + j) * 80 + (16 * kgl + kl) * 2) = f2bf(qv[j] * e);
                *(LAS bf16_t*)(Ks + (8 * seg + j) * 80 + (16 * kgl + kl) * 2) = f2bf(kt); }
            u32x4 khp; khp[0] = cvt_pk_bf16(kh[0], kh[1]); khp[1] = cvt_pk_bf16(kh[2], kh[3]); khp[2] = cvt_pk_bf16(kh[4], kh[5]); khp[3] = cvt_pk_bf16(kh[6], kh[7]);
            *(u32x4*)(fc + kg * 512 + lane * 8) = khp;
            if (seg == 0) dc[16 * kg + kl] = dC;
        }
        bf16x8 Af[2], Bf[2];
#pragma unroll
        for (int st = 0; st < 2; ++st) Af[st] = *(const LAS bf16x8*)(Ks + (16 * st + kl) * 80 + 16 * seg);
#pragma unroll
        for (int tt = 0; tt < 2; ++tt) Bf[tt] = *(const LAS bf16x8*)(Qs + (16 * tt + kl) * 80 + 16 * seg);
#pragma unroll
        for (int st = 0; st < 2; ++st)
#pragma unroll
            for (int tt = 0; tt < 2; ++tt) sc[st][tt] = __builtin_amdgcn_mfma_f32_16x16x32_bf16(Af[st], Bf[tt], sc[st][tt], 0, 0, 0);
#pragma unroll
        for (int tt = 0; tt < 2; ++tt) { const u32x2 lo = *(const LAS u32x2*)(Qs + (16 * tt + kl) * 80 + 8 * seg), hi = *(const LAS u32x2*)(Qs + (16 * tt + kl) * 80 + 32 + 8 * seg);
            *(u32x4*)(qc + (2 * ks + tt) * 512 + lane * 8) = (u32x4){lo.x, lo.y, hi.x, hi.y}; }
    }
#pragma unroll
    for (int tt = 0; tt < 2; ++tt) { const int t = 16 * tt + kl;
#pragma unroll
        for (int r = 0; r < 4; ++r) { const unsigned pk = cvt_pk_bf16((4 * seg + r <= t) ? sc[0][tt][r] : 0.f, (16 + 4 * seg + r <= t) ? sc[1][tt][r] : 0.f);
            *(LAS bf16_t*)(Qs + t * 80 + (4 * seg + r) * 2) = (bf16_t)(pk & 0xffffu); *(LAS bf16_t*)(Qs + t * 80 + (16 + 4 * seg + r) * 2) = (bf16_t)(pk >> 16); } }
    asm volatile("" ::: "memory");
#pragma unroll
    for (int tt = 0; tt < 2; ++tt) { const u32x4 pf = *(const LAS u32x4*)(Qs + (16 * tt + kl) * 80 + 16 * seg); *(u32x4*)(oi + tt * 512 + lane * 8) = pf; }
}

constexpr int OFF_PRIV = 3 * RING, OFF_OT = OFF_PRIV + 3 * 8 * 2048, OFF_OS = OFF_OT + 2 * 32 * OTP, B_END = OFF_OS + 2 * 32 * OTP;
static_assert(B_END <= 163840, "hgrn pass B lds");
#define HGB_DMA(c, stg) do { const size_t ce_ = (size_t)(cbase + (c)) * 4096; LAS unsigned char* sh_ = lds + (stg) * RING; LAS unsigned char* pv_ = lds + OFF_PRIV + ((stg) * 8 + w) * 2048; \
        __builtin_amdgcn_global_load_lds((const unsigned*)(QF + ce_ + w * 512 + lane * 8), (LAS unsigned*)(sh_ + w * 1024), 16, 0, 0); \
        __builtin_amdgcn_global_load_lds((const unsigned*)(KH + ce_ + w * 512 + lane * 8), (LAS unsigned*)(sh_ + 8192 + w * 1024), 16, 0, 0); \
        __builtin_amdgcn_global_load_lds((const unsigned*)(DC + (size_t)(cbase + (c)) * 256 + lane * 4), (LAS unsigned*)(sh_ + 16384), 16, 0, 0); \
        __builtin_amdgcn_global_load_lds((const unsigned*)(IT + ce_ + (16 * w + kl) * 32 + 8 * seg), (LAS unsigned*)(pv_), 16, 0, 0); \
        __builtin_amdgcn_global_load_lds((const unsigned*)(OI + (size_t)(cbase + (c)) * 1024 + (w & 1) * 512 + lane * 8), (LAS unsigned*)(sh_ + 17408 + (w & 1) * 1024), 16, 0, 0); \
        __builtin_amdgcn_global_load_lds((const unsigned*)(GT + ce_ + w * 512 + lane * 8), (LAS unsigned*)(pv_ + 1024), 16, 0, 0); } while (0)
#define HGB_OUT(c, par_) do { const int t_ = tid >> 4, cc_ = tid & 15; \
        const u32x4 r_ = *(const LAS u32x4*)(lds + OFF_OS + (par_) * 32 * OTP + t_ * OTP + cc_ * 16); \
        const u32x4 v_ = *(const LAS u32x4*)(lds + OFF_OT + (par_) * 32 * OTP + t_ * OTP + cc_ * 16); \
        float ss_ = 0.f; \
        _Pragma("unroll") for (int i_ = 0; i_ < 4; ++i_) { const float lo_ = bf_lo(r_[i_]), hi_ = bf_hi(r_[i_]); ss_ += lo_ * lo_ + hi_ * hi_; } \
        ss_ += row_ror_f(ss_, 0x128); ss_ += row_ror_f(ss_, 0x124); ss_ += row_ror_f(ss_, 0x122); ss_ += row_ror_f(ss_, 0x121);   \
        const float rs_ = rsqrtf(ss_ * (1.f / 128.f) + EPS); u32x4 o_; \
        _Pragma("unroll") for (int i_ = 0; i_ < 4; ++i_) o_[i_] = cvt_pk_bf16(bf_lo(v_[i_]) * rs_, bf_hi(v_[i_]) * rs_); \
          \
        asm volatile("global_store_dwordx4 %0, %1, off\n\ts_nop 1" :: "v"(AO + (size_t)(b * SEQ + (c) * 32 + t_) * D + h * 128 + cc_ * 8), "v"(o_) : "memory"); } while (0)

__device__ __forceinline__ void pass_b_item(LAS unsigned char* lds, int b, int h, const bf16_t* QF, const bf16_t* KH, const bf16_t* IT, const bf16_t* GT, const float* DC, const bf16_t* OI, bf16_t* AO, unsigned* flag, unsigned want) {
    int tid = threadIdx.x; asm volatile("" : "+v"(tid));
    const int lane = tid & 63, w = __builtin_amdgcn_readfirstlane(tid >> 6), kl = lane & 15, seg = lane >> 4;
    const int cbase = (b * 8 + h) * 128, NCH = SEQ / 32;
    f32x4 S[8];
#pragma unroll
    for (int kg = 0; kg < 8; ++kg) S[kg] = (f32x4){0.f, 0.f, 0.f, 0.f};
    HGB_DMA(0, 0); HGB_DMA(1, 1);
    asm volatile("s_waitcnt vmcnt(0)" ::: "memory"); __builtin_amdgcn_s_barrier(); asm volatile("" ::: "memory");
    int sc = 0, s2 = 2;
    for (int n = 0; n < NCH; ++n) {
        if (n == NCH / 2 - 2) {
            if (tid == 0) { unsigned sp = 0; while (__hip_atomic_load(flag, __ATOMIC_RELAXED, __HIP_MEMORY_SCOPE_AGENT) < want) { __builtin_amdgcn_s_sleep(2); if (++sp > (1u << 22)) break; }
                __builtin_amdgcn_fence(__ATOMIC_ACQUIRE, "agent"); asm volatile("s_waitcnt vmcnt(0)" ::: "memory"); }
            WG_BAR();
        }
        if (n + 2 < NCH) HGB_DMA(n + 2, s2);
        if (n > 0) HGB_OUT(n - 1, (n - 1) & 1);
        const LAS unsigned char* st = lds + sc * RING; const LAS unsigned char* pv = lds + OFF_PRIV + (sc * 8 + w) * 2048 + lane * 16;
        bf16x8 Sb[4];
#pragma unroll
        for (int ks = 0; ks < 4; ++ks) { const u32x4 pk = (u32x4){cvt_pk_bf16(S[2 * ks][0], S[2 * ks][1]), cvt_pk_bf16(S[2 * ks][2], S[2 * ks][3]), cvt_pk_bf16(S[2 * ks + 1][0], S[2 * ks + 1][1]), cvt_pk_bf16(S[2 * ks + 1][2], S[2 * ks + 1][3])}; Sb[ks] = __builtin_bit_cast(bf16x8, pk); }
        const u32x4 Gc = *(const LAS u32x4*)(pv + 1024);
        const bf16x8 pf0 = *(const LAS bf16x8*)(st + 17408 + lane * 16), pf1 = *(const LAS bf16x8*)(st + 17408 + 1024 + lane * 16);
        f32x4 o[2];
        bf16x8 qa[8], ka[8]; f32x4 dcv[8];
#pragma unroll
        for (int i = 0; i < 8; ++i) qa[i] = *(const LAS bf16x8*)(st + i * 1024 + lane * 16);
        const bf16x8 Vb = *(const LAS bf16x8*)(pv);
#pragma unroll
        for (int kg = 0; kg < 8; ++kg) { dcv[kg] = *(const LAS f32x4*)(st + 16384 + (16 * kg + 4 * seg) * 4); ka[kg] = *(const LAS bf16x8*)(st + 8192 + kg * 1024 + lane * 16); }
        __builtin_amdgcn_sched_barrier(0);
        { const f32x4 z = (f32x4){0.f, 0.f, 0.f, 0.f}; o[0] = __builtin_amdgcn_mfma_f32_16x16x32_bf16(pf0, Vb, z, 0, 0, 0); o[1] = __builtin_amdgcn_mfma_f32_16x16x32_bf16(pf1, Vb, z, 0, 0, 0); }
#pragma unroll
        for (int ks = 0; ks < 4; ++ks)
#pragma unroll
            for (int tt = 0; tt < 2; ++tt) o[tt] = __builtin_amdgcn_mfma_f32_16x16x32_bf16(qa[2 * ks + tt], Sb[ks], o[tt], 0, 0, 0);
#pragma unroll
        for (int kg = 0; kg < 8; ++kg) S[kg] = __builtin_amdgcn_mfma_f32_16x16x32_bf16(ka[kg], Vb, S[kg] * dcv[kg], 0, 0, 0);
        const int par = n & 1;
#pragma unroll
        for (int tt = 0; tt < 2; ++tt) { const float gv[4] = {bf_lo(Gc[2 * tt]), bf_hi(Gc[2 * tt]), bf_lo(Gc[2 * tt + 1]), bf_hi(Gc[2 * tt + 1])};
#pragma unroll
            for (int r = 0; r < 4; ++r) { const int t = 16 * tt + 4 * seg + r; const unsigned pk = cvt_pk_bf16(o[tt][r], o[tt][r] * gv[r]);
                *(LAS bf16_t*)(lds + OFF_OS + par * 32 * OTP + t * OTP + (16 * w + kl) * 2) = (bf16_t)(pk & 0xffffu);
                *(LAS bf16_t*)(lds + OFF_OT + par * 32 * OTP + t * OTP + (16 * w + kl) * 2) = (bf16_t)(pk >> 16); } }
        if (n + 2 < NCH) asm volatile("s_waitcnt vmcnt(6)" ::: "memory"); else asm volatile("s_waitcnt vmcnt(0)" ::: "memory");
        WG_BAR();
        sc = sc == 2 ? 0 : sc + 1; s2 = s2 == 2 ? 0 : s2 + 1;
    }
    HGB_OUT(NCH - 1, (NCH - 1) & 1);
    asm volatile("s_waitcnt vmcnt(0)" ::: "memory");
    WG_BAR();
}
}

namespace att {
constexpr int KP = 144, VP = 528, OFF_K = 0, OFF_V = 256 * KP;
static_assert(OFF_V + 64 * VP <= 131072, "attn lds");
__device__ __forceinline__ void attn_item(LAS unsigned char* lds, int b, int kvh, int nb, const bf16_t* QB, const bf16_t* KB, const bf16_t* VT, bf16_t* OB, const float* sinks) {
    int tid = threadIdx.x; asm volatile("" : "+v"(tid));
    const int lane = tid & 63, w = __builtin_amdgcn_readfirstlane(tid >> 6), kl = lane & 15, seg = lane >> 4;
    LAS unsigned char* Kl = lds + OFF_K; LAS unsigned char* Vl = lds + OFF_V;
    const int sbase = 128 * (nb - 1);
#pragma unroll
    for (int i = 0; i < 4; ++i) { const int id = tid + 512 * i, row = id >> 3, cchunk = id & 7, s = sbase + row;
        u32x4 v = (u32x4){0u, 0u, 0u, 0u}; if (s >= 0) v = *(const u32x4*)(KB + (size_t)(b * SEQ + s) * 128 + kvh * 64 + cchunk * 8);
        *(LAS u32x4*)(Kl + row * KP + cchunk * 16) = v; }
#pragma unroll
    for (int i = 0; i < 4; ++i) { const int id = tid + 512 * i, d = id >> 5, cchunk = id & 31, key0 = cchunk * 8, blk = nb - 1 + (key0 >> 7);
        u32x4 v = (u32x4){0u, 0u, 0u, 0u}; if (blk >= 0) v = *(const u32x4*)(VT + ((size_t)(((b * 2 + kvh) * 32 + blk) * 64 + d)) * 128 + (key0 & 127));
        *(LAS u32x4*)(Vl + d * VP + cchunk * 16) = v; }
    WG_BAR();
    const int head = kvh * 8 + w;
    const float slope2 = ex2(-0.5f * (float)(head + 1)) * LOG2E, sink2 = sinks[head] * LOG2E;
    for (int qb = 0; qb < 8; ++qb) {
        const size_t rowq = (size_t)(b * SEQ + nb * 128 + 16 * qb + kl);
        bf16x8 qf[2];
#pragma unroll
        for (int ks = 0; ks < 2; ++ks) qf[ks] = *(const bf16x8*)(QB + rowq * D + head * 64 + 32 * ks + 8 * seg);
        const int kt0 = qb < 6 ? qb : 6;
        f32x4 sc[10];
#pragma unroll
        for (int jt = 0; jt < 10; ++jt) { sc[jt] = (f32x4){0.f, 0.f, 0.f, 0.f};
#pragma unroll
            for (int ks = 0; ks < 2; ++ks) { const bf16x8 a = *(const LAS bf16x8*)(Kl + (16 * (kt0 + jt) + kl) * KP + (32 * ks + 8 * seg) * 2); sc[jt] = __builtin_amdgcn_mfma_f32_16x16x32_bf16(a, qf[ks], sc[jt], 0, 0, 0); } }
        const int iq = 16 * qb + kl, dbase = 128 + iq - 16 * kt0 - 4 * seg; const unsigned dlim = nb > 0 ? 127u : (unsigned)iq;
        float mx = -INFINITY;
#pragma unroll
        for (int jt = 0; jt < 10; ++jt)
#pragma unroll
            for (int r = 0; r < 4; ++r) { const int dist = dbase - (16 * jt + r);
                const float v = ((unsigned)dist <= dlim) ? sc[jt][r] - slope2 * (float)dist : -INFINITY; sc[jt][r] = v; mx = fmaxf(mx, v); }
        mx = fmaxf(mx, __shfl_xor(mx, 16)); mx = fmaxf(mx, __shfl_xor(mx, 32)); mx = fmaxf(mx, sink2);
        float sum = 0.f;
#pragma unroll
        for (int jt = 0; jt < 10; ++jt)
#pragma unroll
            for (int r = 0; r < 4; ++r) { const float e = ex2(sc[jt][r] - mx); sc[jt][r] = e; sum += e; }
        sum += __shfl_xor(sum, 16); sum += __shfl_xor(sum, 32);
        const float inv = 1.f / (sum + ex2(sink2 - mx));
        bf16x8 pB[5];
#pragma unroll
        for (int kb = 0; kb < 5; ++kb) { u32x4 pk; pk[0] = cvt_pk_bf16(sc[2 * kb][0], sc[2 * kb][1]); pk[1] = cvt_pk_bf16(sc[2 * kb][2], sc[2 * kb][3]); pk[2] = cvt_pk_bf16(sc[2 * kb + 1][0], sc[2 * kb + 1][1]); pk[3] = cvt_pk_bf16(sc[2 * kb + 1][2], sc[2 * kb + 1][3]);
            pB[kb] = __builtin_bit_cast(bf16x8, pk); }
#pragma unroll
        for (int dt = 0; dt < 4; ++dt) {
            f32x4 o = (f32x4){0.f, 0.f, 0.f, 0.f};
#pragma unroll
            for (int kb = 0; kb < 5; ++kb) { const LAS unsigned char* vp = Vl + (16 * dt + kl) * VP + (16 * (kt0 + 2 * kb) + 4 * seg) * 2;
                const u32x2 lo = *(const LAS u32x2*)(vp), hi = *(const LAS u32x2*)(vp + 32);
                const u32x4 av = (u32x4){lo.x, lo.y, hi.x, hi.y};
                o = __builtin_amdgcn_mfma_f32_16x16x32_bf16(__builtin_bit_cast(bf16x8, av), pB[kb], o, 0, 0, 0); }
            u32x2 wv; wv.x = cvt_pk_bf16(o[0] * inv, o[1] * inv); wv.y = cvt_pk_bf16(o[2] * inv, o[3] * inv);
            *(u32x2*)(OB + rowq * D + head * 64 + 16 * dt + 4 * seg) = wv;
        }
    }
    WG_BAR();
}
}

__device__ __forceinline__ float wave_sum(float v) {
#pragma unroll
    for (int o = 1; o < 64; o <<= 1) v += __shfl_xor(v, o);
    return v;
}
__device__ __forceinline__ void transpose_item(const float* W, int K, int N, bf16_t* WT, int row_off, int mode, const float* gain, int gmask, float scale, LAS float* scr, int item, int lane) {
    const int nblk = N / 32, kb = item / nblk, nb = item % nblk, k0 = 64 * kb, n0 = 32 * nb;
#pragma unroll 8
    for (int i = 0; i < 32; ++i) { const int kk = 2 * i + (lane >> 5); const float gsc = gain ? gain[(k0 + kk) & gmask] * scale : scale; scr[kk * 33 + (lane & 31)] = W[(size_t)(k0 + kk) * N + n0 + (lane & 31)] * gsc; }
    LDS_WAIT(); asm volatile("" ::: "memory");
    const int c = lane & 7;
#pragma unroll
    for (int j = 0; j < 4; ++j) { const int nl = (lane >> 3) + 8 * j, n = n0 + nl; const LAS float* s = scr + (8 * c) * 33 + nl;
        u32x4 o; o.x = cvt_pk_bf16(s[0 * 33], s[1 * 33]); o.y = cvt_pk_bf16(s[2 * 33], s[3 * 33]); o.z = cvt_pk_bf16(s[4 * 33], s[5 * 33]); o.w = cvt_pk_bf16(s[6 * 33], s[7 * 33]);
        int drow; if (mode == 0) drow = row_off + n; else { const int isv = n >= DFF ? 1 : 0, f = n - isv * DFF; drow = 256 * (f >> 7) + 128 * isv + (f & 127); }
        *(u32x4*)(WT + (size_t)drow * K + k0 + 8 * c) = o; }
    LDS_WAIT(); asm volatile("" ::: "memory");
}


#define XB_TMO      128
#define XB_XCNT(j)  (256  + 64 * (j))
#define XB_XSUB(j)  (1280 + 64 * (j))
#define XB_XGEN(j)  (2304 + 64 * (j))
#define XB_TOP      3328
#define XB_TOPGEN   3392
#define XCD_BAR_WORDS 3456
#define XB_SPIN_CAP (1u << 18)
__device__ __forceinline__ unsigned xb_ld(unsigned* p)              { return __hip_atomic_load(p, __ATOMIC_RELAXED, __HIP_MEMORY_SCOPE_AGENT); }
__device__ __forceinline__ unsigned xb_add(unsigned* p, unsigned v) { return __hip_atomic_fetch_add(p, v, __ATOMIC_RELAXED, __HIP_MEMORY_SCOPE_AGENT); }
__device__ __forceinline__ unsigned xb_xcc_id() { return (unsigned)__builtin_amdgcn_s_getreg((3 << 11) | 20) & 0xFu; }
#define XB_SPIN(cond, bar) do { unsigned _sp = 0; while (cond) { __builtin_amdgcn_s_sleep(1); \
    if ((++_sp & 255u) == 0u) { if (xb_ld(&(bar)[XB_TMO])) break; if (_sp > XB_SPIN_CAP) { atomicAdd(&(bar)[XB_TMO], 1u); break; } } } } while (0)
struct XcdBarrier { unsigned* bar; unsigned x; volatile LAS unsigned* st; };
__device__ __forceinline__ XcdBarrier xcd_barrier_post(unsigned* bar, volatile LAS unsigned* st) {
    XcdBarrier b; b.bar = bar; b.x = xb_xcc_id(); b.st = st;
    if (threadIdx.x == 0) (void)xb_add(&bar[XB_XCNT(b.x)], 1u);
    return b;
}
__device__ __forceinline__ void xcd_barrier_complete(unsigned* bar, unsigned x, unsigned& nloc, unsigned& nx) {
    const unsigned G = gridDim.x * gridDim.y * gridDim.z;
    unsigned sum, cnt, mine, sp = 0u;
    for (;;) {
        sum = 0u; cnt = 0u; mine = 0u;
#pragma unroll
        for (unsigned j = 0; j < 16; ++j) { const unsigned c = xb_ld(&bar[XB_XCNT(j)]); sum += c; cnt += (c > 0u) ? 1u : 0u; mine = (j == x) ? c : mine; }
        if (sum == G) break;
        __builtin_amdgcn_s_sleep(1);
        if ((++sp & 255u) == 0u) { if (xb_ld(&bar[XB_TMO])) break; if (sp > XB_SPIN_CAP) { atomicAdd(&bar[XB_TMO], 1u); break; } }
    }
    nloc = mine > 0u ? mine : 1u; nx = cnt > 0u ? cnt : 1u;
}
__device__ __forceinline__ void xcd_barrier(const XcdBarrier& b) {
    asm volatile("s_waitcnt vmcnt(0)" ::: "memory");
    __syncthreads();
    if (threadIdx.x == 0) {
        unsigned* bar = b.bar;
        __builtin_amdgcn_s_waitcnt(0);
        unsigned nloc = b.st[0], nx = b.st[1];
        if (nloc == 0u) { xcd_barrier_complete(bar, b.x, nloc, nx); b.st[0] = nloc; b.st[1] = nx; }
        const unsigned old = xb_add(&bar[XB_XSUB(b.x)], 1u);
        const unsigned gen = old / nloc;
        if (old + 1u == (gen + 1u) * nloc) {
            __builtin_amdgcn_fence(__ATOMIC_RELEASE, "agent");
            asm volatile("s_waitcnt vmcnt(0)" ::: "memory");
            const unsigned og = xb_add(&bar[XB_TOP], 1u);
            const unsigned tg = og / nx;
            if (og + 1u == (tg + 1u) * nx) xb_add(&bar[XB_TOPGEN], 1u);
            else XB_SPIN(xb_ld(&bar[XB_TOPGEN]) == tg, bar);
            __builtin_amdgcn_fence(__ATOMIC_ACQUIRE, "agent");
            xb_add(&bar[XB_XGEN(b.x)], 1u);
            asm volatile("s_waitcnt vmcnt(0)" ::: "memory");
        } else {
            XB_SPIN(xb_ld(&bar[XB_XGEN(b.x)]) == gen, bar);
            __builtin_amdgcn_fence(__ATOMIC_ACQUIRE, "agent");
            asm volatile("s_waitcnt vmcnt(0)" ::: "memory");
        }
    }
    __syncthreads();
}


__device__ __forceinline__ void ffn_fixup(const pg8::StaticOrder& S, bf16_t* Uo, const float* GH, const float* GS, const float* VS, const float* cw, const float* cb) {
    pg8::Unit u;
    for (int i = 0; S.next(i, u); ++i) {
        const int pm = u.pm; if ((pm & 15) == 0) continue;
#pragma unroll
        for (int it = 0; it < 2; ++it) {
            const int q = (int)threadIdx.x + 512 * it;
            if (q < DFF / 4) {
                const int f = 4 * q;
                const f32x4 g254 = *(const f32x4*)(GH + (size_t)((pm - 1) * 2 + 0) * DFF + f), g255 = *(const f32x4*)(GH + (size_t)((pm - 1) * 2 + 1) * DFF + f);
                const f32x4 g0 = *(const f32x4*)(GS + (size_t)(pm * 2 + 0) * DFF + f), g1 = *(const f32x4*)(GS + (size_t)(pm * 2 + 1) * DFF + f);
                const f32x4 v0 = *(const f32x4*)(VS + (size_t)(pm * 2 + 0) * DFF + f), v1 = *(const f32x4*)(VS + (size_t)(pm * 2 + 1) * DFF + f);
                const f32x4 w0 = *(const f32x4*)(cw + f), w1 = *(const f32x4*)(cw + DFF + f), w2 = *(const f32x4*)(cw + 2 * DFF + f), bb = *(const f32x4*)(cb + f);
                const f32x4 c0 = bb + w0 * g254 + w1 * g255 + w2 * g0, c1 = bb + w0 * g255 + w1 * g0 + w2 * g1;
                u32x2 o0, o1;
                o0[0] = cvt_pk_bf16(silu_f(c0[0]) * v0[0], silu_f(c0[1]) * v0[1]); o0[1] = cvt_pk_bf16(silu_f(c0[2]) * v0[2], silu_f(c0[3]) * v0[3]);
                o1[0] = cvt_pk_bf16(silu_f(c1[0]) * v1[0], silu_f(c1[1]) * v1[1]); o1[1] = cvt_pk_bf16(silu_f(c1[2]) * v1[2], silu_f(c1[3]) * v1[3]);
                *(u32x2*)(Uo + (size_t)(pm * 256 + 0) * DFF + f) = o0; *(u32x2*)(Uo + (size_t)(pm * 256 + 1) * DFF + f) = o1;
            }
        }
    }
    asm volatile("s_waitcnt vmcnt(0)" ::: "memory");
    __syncthreads();
}

struct Params {
    const float* in[18];
    float* out; unsigned char* ws;
};

constexpr int LDS_HALO_OFF = 131072;
constexpr int LDS_BYTES = 163840;
constexpr int LDS_XB_OFF = 163328;

__global__ void __launch_bounds__(512, 2) yoco_fwd(Params P) {
    extern __shared__ __attribute__((aligned(16))) unsigned char lds_raw[];
    LAS unsigned char* lds = (LAS unsigned char*)lds_raw;
    cg::grid_group grid = cg::this_grid();
    const int tid = threadIdx.x, lane = tid & 63, wave = __builtin_amdgcn_readfirstlane(tid >> 6);
    const int G = gridDim.x, bx = blockIdx.x;
#define x ((const float*)P.in[0])
#define hg_norm ((const float*)P.in[1])
#define hg_w_in ((const float*)P.in[2])
#define hg_lb ((const float*)P.in[3])
#define hg_out_norm ((const float*)P.in[4])
#define hg_w_out ((const float*)P.in[5])
#define kv_norm ((const float*)P.in[6])
#define w_kv ((const float*)P.in[7])
#define attn_norm ((const float*)P.in[8])
#define attn_w_q ((const float*)P.in[9])
#define attn_sinks ((const float*)P.in[10])
#define attn_w_o ((const float*)P.in[11])
#define ffn_norm ((const float*)P.in[12])
#define ffn_w_up ((const float*)P.in[13])
#define ffn_conv_w ((const float*)P.in[14])
#define ffn_conv_b ((const float*)P.in[15])
#define ffn_w_down ((const float*)P.in[16])
#define final_norm ((const float*)P.in[17])
#define RS ((float*)(P.ws + WS_RS))
#define WinT ((bf16_t*)(P.ws + WS_WIN))
#define WoutT ((bf16_t*)(P.ws + WS_WOUT))
#define WupT0 ((bf16_t*)(P.ws + WS_WUP0))
#define WdT0 ((bf16_t*)(P.ws + WS_WD0))
#define WqkvT ((bf16_t*)(P.ws + WS_WQKV))
#define WoT ((bf16_t*)(P.ws + WS_WO))
#define WupT1 ((bf16_t*)(P.ws + WS_WUP1))
#define WdT1 ((bf16_t*)(P.ws + WS_WD1))
#define HB ((bf16_t*)(P.ws + WS_HB))
#define H ((float*)(P.ws + WS_H))
#define QT ((bf16_t*)(P.ws + WS_QT))
#define FT ((bf16_t*)(P.ws + WS_FT))
#define IT ((bf16_t*)(P.ws + WS_IT))
#define GT ((bf16_t*)(P.ws + WS_GT))
#define AO ((bf16_t*)(P.ws + WS_AO))
#define OI ((bf16_t*)(P.ws + WS_OI))
#define DC ((float*)(P.ws + WS_DC))
#define U ((bf16_t*)(P.ws + WS_U))
#define QB ((bf16_t*)(P.ws + WS_QB))
#define KB ((bf16_t*)(P.ws + WS_KB))
#define VT ((bf16_t*)(P.ws + WS_VT))
#define OB ((bf16_t*)(P.ws + WS_OB))
#define FGH ((float*)(P.ws + WS_H))
#define FGS ((float*)(P.ws + WS_H + 4 * MiB))
#define FVS ((float*)(P.ws + WS_H + 8 * MiB))
    const int gw = bx * 8 + wave, NGW = G * 8;

    {
        LAS float* scr = (LAS float*)(lds + wave * 16384);
        for (int it = gw; it < 16 * 128; it += NGW) transpose_item(hg_w_in, D, 4 * D, WinT, 0, 0, hg_norm, 1023, 1.f, scr, it, lane);
        for (int m = gw; m < M; m += 2 * NGW) {
            const int m2 = (m + NGW < M) ? m + NGW : m;
            const f32x4* xr = (const f32x4*)(x + (size_t)m * D) + lane; const f32x4* xr2 = (const f32x4*)(x + (size_t)m2 * D) + lane;
            f32x4 va[4], vb[4];
#pragma unroll
            for (int j = 0; j < 4; ++j) { va[j] = xr[64 * j]; vb[j] = xr2[64 * j]; }
            float s = 0.f, s2 = 0.f;
            unsigned long long* o8 = (unsigned long long*)(HB + (size_t)m * D) + lane; unsigned long long* o82 = (unsigned long long*)(HB + (size_t)m2 * D) + lane;
#pragma unroll
            for (int j = 0; j < 4; ++j) { const f32x4 v = va[j], w2 = vb[j];
                s += (v[0] * v[0] + v[1] * v[1]) + (v[2] * v[2] + v[3] * v[3]); s2 += (w2[0] * w2[0] + w2[1] * w2[1]) + (w2[2] * w2[2] + w2[3] * w2[3]);
                o8[64 * j] = (unsigned long long)cvt_pk_bf16(v[0], v[1]) | ((unsigned long long)cvt_pk_bf16(v[2], v[3]) << 32);
                if (m2 != m) o82[64 * j] = (unsigned long long)cvt_pk_bf16(w2[0], w2[1]) | ((unsigned long long)cvt_pk_bf16(w2[2], w2[3]) << 32); }
            s = wave_sum(s); s2 = wave_sum(s2);
            if (lane == 0) { RS[m] = s; if (m2 != m) RS[m2] = s2; }
        }
        for (int i = bx * 512 + tid; i < 4 * M; i += G * 512) RS[M + i] = 0.f;
        if (bx == 0) for (int i = tid; i < XCD_BAR_WORDS; i += 512) ((unsigned*)(P.ws + WS_BAR))[i] = 0u;
        if (tid < 2) ((LAS unsigned*)(lds + LDS_XB_OFF))[tid] = 0u;
    }
    grid.sync();
    const XcdBarrier xbar = xcd_barrier_post((unsigned*)(P.ws + WS_BAR), (volatile LAS unsigned*)(lds + LDS_XB_OFF));

    {
        pg8::Gemm g{HB, WinT, M, 4 * D, D}; pg8::StaticOrder S; S.init(M / 256, 16, G, bx, 0);
        pg8::EpiHg E{P.ws, RS, hg_lb};
        pg8::gemm_phase<pg8::EpiHg, true>(lds, g, S, E);
    }
    xcd_barrier(xbar);

    for (int c = gw; c < 4096; c += NGW) hg::pass_a_chunk(lds + wave * hg::A_WAVE_LDS, (c & 63) * 128 + (c >> 6), QT, FT, IT, DC, OI, lane);
    xcd_barrier(xbar);
    unsigned* hgflag = (unsigned*)(P.ws + WS_BAR) + 3424;
    if (bx < 64) { for (int item = bx; item < 64; item += G) hg::pass_b_item(lds, item >> 3, item & 7, QT, FT, IT, GT, DC, OI, AO, hgflag, (unsigned)(G - 64)); }
    else {
        for (int c = (bx - 64) * 8 + wave; c < 4096; c += (G - 64) * 8) hg::pass_a_chunk(lds + wave * hg::A_WAVE_LDS, (c & 63) * 128 + 64 + (c >> 6), QT, FT, IT, DC, OI, lane);
        asm volatile("s_waitcnt vmcnt(0)" ::: "memory"); __syncthreads();
        if (tid == 0) { __builtin_amdgcn_fence(__ATOMIC_RELEASE, "agent"); asm volatile("s_waitcnt vmcnt(0)" ::: "memory"); __hip_atomic_fetch_add(hgflag, 1u, __ATOMIC_RELAXED, __HIP_MEMORY_SCOPE_AGENT); }
        LAS float* scr = (LAS float*)(lds + wave * 16384);
        constexpr int I_SQ = 16 * 32, I_UP = 16 * 176, I_DN = 44 * 32, I_KV = 16 * 8;
        constexpr int NIT = I_SQ + 2 * I_UP + 2 * I_DN + I_SQ + I_KV + I_SQ;
        for (int it = (bx - 64) * 8 + wave; it < NIT; it += (G - 64) * 8) {
            int r = it;
            if (r < I_SQ) { transpose_item(hg_w_out, D, D, WoutT, 0, 0, hg_out_norm, 127, 1.f, scr, r, lane); continue; } r -= I_SQ;
            if (r < I_UP) { transpose_item(ffn_w_up, D, 2 * DFF, WupT0, 0, 1, ffn_norm, 1023, 1.f, scr, r, lane); continue; } r -= I_UP;
            if (r < I_UP) { transpose_item(ffn_w_up + (size_t)D * 2 * DFF, D, 2 * DFF, WupT1, 0, 1, ffn_norm + D, 1023, 1.f, scr, r, lane); continue; } r -= I_UP;
            if (r < I_DN) { transpose_item(ffn_w_down, DFF, D, WdT0, 0, 0, nullptr, 0, 1.f, scr, r, lane); continue; } r -= I_DN;
            if (r < I_DN) { transpose_item(ffn_w_down + (size_t)DFF * D, DFF, D, WdT1, 0, 0, nullptr, 0, 1.f, scr, r, lane); continue; } r -= I_DN;
            if (r < I_SQ) { transpose_item(attn_w_q, D, D, WqkvT, 0, 0, attn_norm, 1023, 0.125f * LOG2E, scr, r, lane); continue; } r -= I_SQ;
            if (r < I_KV) { transpose_item(w_kv, D, 256, WqkvT, 1024, 0, kv_norm, 1023, 1.f, scr, r, lane); continue; } r -= I_KV;
            transpose_item(attn_w_o, D, D, WoT, 0, 0, nullptr, 0, 1.f, scr, r, lane);
        }
    }
    xcd_barrier(xbar);

    {
        pg8::Gemm g{AO, WoutT, M, D, D}; pg8::StaticOrder S; S.init(M / 256, 4, G, bx, 0);
        pg8::EpiRes E{HB, RS + M};
        pg8::gemm_phase<pg8::EpiRes, false, true>(lds, g, S, E);
    }
    xcd_barrier(xbar);

#define FFN_LAYER(layer) do { \
        { pg8::Gemm g{HB, layer == 0 ? WupT0 : WupT1, M, 2 * DFF, D}; pg8::StaticOrder S; S.init(M / 256, 22, G, bx, 0); \
          pg8::EpiFfn E{U, RS + (layer == 0 ? 1 : 3) * M, ffn_conv_w + (size_t)layer * 3 * DFF, ffn_conv_b + (size_t)layer * DFF, (LAS float*)(lds + LDS_HALO_OFF), FGH, FGS, FVS}; \
          pg8::gemm_phase<pg8::EpiFfn, false, true>(lds, g, S, E); } \
        xcd_barrier(xbar); \
        { pg8::Gemm g{U, layer == 0 ? WdT0 : WdT1, M, D, DFF}; pg8::StaticOrder S; S.init(M / 256, 4, G, bx, 0); \
          ffn_fixup(S, U, FGH, FGS, FVS, ffn_conv_w + (size_t)layer * 3 * DFF, ffn_conv_b + (size_t)layer * DFF); \
          pg8::EpiRes E{HB, RS + (layer == 0 ? 2 : 4) * M}; \
          pg8::gemm_phase<pg8::EpiRes, false, true>(lds, g, S, E); } \
        xcd_barrier(xbar); } while (0)

    FFN_LAYER(0);
    {
        pg8::Gemm g{HB, WqkvT, M, 1280, D}; pg8::StaticOrder S; S.init(M / 256, 5, G, bx, 0);
        pg8::EpiQkv E{QB, KB, VT, RS + 2 * M};
        pg8::gemm_phase<pg8::EpiQkv, false, true>(lds, g, S, E);
    }
    xcd_barrier(xbar);
    for (int item = bx; item < 512; item += G) { const int nb = item & 31, kvh = (item >> 5) & 1, b = item >> 6; att::attn_item(lds, b, kvh, nb, QB, KB, VT, OB, attn_sinks); }
    xcd_barrier(xbar);
    {
        pg8::Gemm g{OB, WoT, M, D, D}; pg8::StaticOrder S; S.init(M / 256, 4, G, bx, 0);
        pg8::EpiRes E{HB, RS + 3 * M};
        pg8::gemm_phase<pg8::EpiRes, false, true>(lds, g, S, E);
    }
    xcd_barrier(xbar);
    FFN_LAYER(1);

    for (int m = gw; m < M; m += 4 * NGW) {
        int mr[4]; float rr[4]; u32x2 hv[4][4];
#pragma unroll
        for (int q = 0; q < 4; ++q) { mr[q] = (m + q * NGW < M) ? m + q * NGW : m; rr[q] = RS[4 * M + mr[q]]; }
#pragma unroll
        for (int q = 0; q < 4; ++q) { const u32x2* hrow = (const u32x2*)(HB + (size_t)mr[q] * D) + lane;
#pragma unroll
            for (int j = 0; j < 4; ++j) hv[q][j] = hrow[64 * j]; }
        const f32x4* gn = (const f32x4*)final_norm + lane;
#pragma unroll
        for (int q = 0; q < 4; ++q) { if (q > 0 && mr[q] == m) continue;
            const float rs = rsqrtf(rr[q] * (1.f / D) + EPS); f32x4* orow = (f32x4*)(P.out + (size_t)mr[q] * D) + lane;
#pragma unroll
            for (int j = 0; j < 4; ++j) { const f32x4 v = (f32x4){bf_lo(hv[q][j][0]), bf_hi(hv[q][j][0]), bf_lo(hv[q][j][1]), bf_hi(hv[q][j][1])}; orow[64 * j] = v * rs * gn[64 * j]; } }
    }
}

extern "C" void kernel_launch(void* const* d_in, const int* in_sizes, int n_in, void* d_out, int out_size, void* d_ws, size_t ws_size, hipStream_t stream) {
    static int grid_blocks = 0;
    if (grid_blocks == 0) {
        if (n_in != 18 || in_sizes[0] != M * D || out_size != M * D || ws_size < WS_END) { fprintf(stderr, "kernel_launch: unexpected shapes (n_in %d, in0 %d, out %d, ws %zu)\n", n_in, n_in > 0 ? in_sizes[0] : -1, out_size, ws_size); grid_blocks = -1; return; }
        int dev = 0, cus = 0, per_cu = 0;
        hipGetDevice(&dev);
        hipDeviceGetAttribute(&cus, hipDeviceAttributeMultiprocessorCount, dev);
        hipFuncSetAttribute((const void*)yoco_fwd, hipFuncAttributeMaxDynamicSharedMemorySize, LDS_BYTES);
        hipOccupancyMaxActiveBlocksPerMultiprocessor(&per_cu, (const void*)yoco_fwd, 512, LDS_BYTES);
        if (per_cu < 1) { fprintf(stderr, "kernel_launch: occupancy query says %d blocks per CU\n", per_cu); grid_blocks = -1; return; }
        grid_blocks = cus;
    }
    if (grid_blocks < 0) return;
    Params p{};
    for (int i = 0; i < 18; ++i) p.in[i] = (const float*)d_in[i];
    p.out = (float*)d_out; p.ws = (unsigned char*)d_ws;
    void* args[] = {&p};
    hipError_t e = hipLaunchCooperativeKernel((const void*)yoco_fwd, dim3(grid_blocks), dim3(512), args, LDS_BYTES, stream);
    if (e != hipSuccess) fprintf(stderr, "cooperative launch failed: %s (grid %d)\n", hipGetErrorString(e), grid_blocks);
}
```
